# Optimizing an MI355X kernel written in HIP

```python
import math
import jax, jax.numpy as jnp
from jax import lax
import numpy as np

D_MODEL = 1024
BATCH = 8
SEQ = 4096
DEPTH = 4

POOL_WINDOWS = (2, 4, 8, 16)
POOL_GROUP = D_MODEL // 16
D_A = POOL_GROUP * len(POOL_WINDOWS)
N_HEADS = 8
HEAD_DIM = 64
D_B = N_HEADS * HEAD_DIM
Q_BLOCK = 128
SSM_GROUP = 16
D_C = D_MODEL // 4
SSM_GROUPS = D_C // SSM_GROUP
SSM_STATE = 64
DT_MIN = 0.001
DT_MAX = 0.1
DEEPNORM_ALPHA = (2.0 * DEPTH) ** 0.25
DEEPNORM_BETA = (8.0 * DEPTH) ** -0.25
LN_EPS = 1e-5
N_BRANCHES = 3

IN_SIZES = (D_A, D_A,
            D_B, D_B, D_B,
            N_HEADS,
            D_B,
            D_C, D_C,
            N_BRANCHES * D_MODEL)
IN_SPLITS = tuple(int(v) for v in np.cumsum(IN_SIZES)[:-1])
D_IN = int(sum(IN_SIZES))
F_OFFSET = D_A * 2 + D_B * 3

kernel_name = "hybrid_pool_fox_s5_gated_deepnorm"


def layer_norm(x, g, b):
    xf = x.astype(jnp.float32)
    mu = jnp.mean(xf, axis=-1, keepdims=True)
    var = jnp.mean(jnp.square(xf - mu), axis=-1, keepdims=True)
    y = (xf - mu) * lax.rsqrt(var + LN_EPS) * g.astype(jnp.float32) + b.astype(jnp.float32)
    return y.astype(x.dtype)


def pool_mixer(u, pool_w, pool_scale):
    b, s, _ = u.shape
    uf = u.astype(jnp.float32).reshape(b, s, len(POOL_WINDOWS), POOL_GROUP)
    csum = jnp.cumsum(uf, axis=1)
    pos = jnp.arange(s)
    outs = []
    for gi, w in enumerate(POOL_WINDOWS):
        cg = csum[:, :, gi]
        shifted = jnp.concatenate([jnp.zeros((b, w, POOL_GROUP), jnp.float32), cg], axis=1)[:, :s]
        count = jnp.minimum(pos + 1, w).astype(jnp.float32)[None, :, None]
        pooled = (cg - shifted) / count - uf[:, :, gi]
        outs.append(jnp.einsum('bsc,ce->bse', pooled, pool_w[gi].astype(jnp.float32)))
    y = jnp.concatenate(outs, axis=-1) * pool_scale.astype(jnp.float32)
    return y


def fox_attention(q, k, v, f_logit):
    b, s, h, dh = q.shape
    nb = s // Q_BLOCK
    logf = jax.nn.log_sigmoid(f_logit.astype(jnp.float32))
    fcum = jnp.cumsum(logf, axis=1)
    fk = jnp.transpose(fcum, (0, 2, 1))
    qb = jnp.moveaxis(q.reshape(b, nb, Q_BLOCK, h, dh), 1, 0)
    fqb = jnp.moveaxis(fcum.reshape(b, nb, Q_BLOCK, h), 1, 0)
    key_pos = jnp.arange(s)
    scale = 1.0 / math.sqrt(dh)

    def one_block(args):
        qi, fqi, bi = args
        scores = jnp.einsum('bqhd,bkhd->bhqk', qi, k,
                            preferred_element_type=jnp.float32) * scale
        bias = jnp.transpose(fqi, (0, 2, 1))[..., None] - fk[:, :, None, :]
        q_pos = bi * Q_BLOCK + jnp.arange(Q_BLOCK)
        mask = key_pos[None, :] <= q_pos[:, None]
        logits = jnp.where(mask[None, None], scores + bias, -jnp.inf)
        p = jax.nn.softmax(logits, axis=-1)
        return jnp.einsum('bhqk,bkhd->bqhd', p, v.astype(jnp.float32))

    out = lax.map(one_block, (qb, fqb, jnp.arange(nb)))
    return jnp.moveaxis(out, 0, 1).reshape(b, s, h * dh)


def _ssm_combine(e1, e2):
    a1r, a1i, b1r, b1i = e1
    a2r, a2i, b2r, b2i = e2
    ar = a1r * a2r - a1i * a2i
    ai = a1r * a2i + a1i * a2r
    br = a2r * b1r - a2i * b1i + b2r
    bi = a2r * b1i + a2i * b1r + b2i
    return (ar, ai, br, bi)


def s5_mixer(u, a_re, a_im, log_dt, b_re, b_im, c_re, c_im, d_skip, w_glu, b_glu):
    b, s, _ = u.shape
    uf = u.astype(jnp.float32)
    ug = uf.reshape(b, s, SSM_GROUPS, SSM_GROUP)
    are = a_re.astype(jnp.float32)
    aim = a_im.astype(jnp.float32)
    dt = jnp.exp(log_dt.astype(jnp.float32))[:, None]
    mag = jnp.exp(are * dt)
    ang = aim * dt
    abar_re = mag * jnp.cos(ang)
    abar_im = mag * jnp.sin(ang)
    den = are * are + aim * aim
    nr = abar_re - 1.0
    coef_re = (nr * are + abar_im * aim) / den
    coef_im = (abar_im * are - nr * aim) / den
    br_ = b_re.astype(jnp.float32)
    bi_ = b_im.astype(jnp.float32)
    bb_re = coef_re[..., None] * br_ - coef_im[..., None] * bi_
    bb_im = coef_re[..., None] * bi_ + coef_im[..., None] * br_
    bu_re = jnp.einsum('bsgh,gph->bsgp', ug, bb_re)
    bu_im = jnp.einsum('bsgh,gph->bsgp', ug, bb_im)
    a_full_re = jnp.broadcast_to(abar_re, bu_re.shape)
    a_full_im = jnp.broadcast_to(abar_im, bu_im.shape)
    _, _, xr, xi = lax.associative_scan(_ssm_combine, (a_full_re, a_full_im, bu_re, bu_im), axis=1)
    y = (jnp.einsum('ghp,bsgp->bsgh', c_re.astype(jnp.float32), xr)
         - jnp.einsum('ghp,bsgp->bsgh', c_im.astype(jnp.float32), xi)).reshape(b, s, D_C)
    y = y + d_skip.astype(jnp.float32) * uf
    y = jax.nn.gelu(y)
    return y * jax.nn.sigmoid(jnp.einsum('bsc,ce->bse', y, w_glu.astype(jnp.float32))
                              + b_glu.astype(jnp.float32))


def hybrid_layer(x, w_in, b_in, pool_w, pool_scale, a_re, a_im, log_dt, b_re, b_im, c_re, c_im,
                 d_skip, w_glu, b_glu, w_up_a, w_up_b, w_up_c, w_out, ln_g, ln_b):
    b, s, _ = x.shape
    z = jnp.einsum('bsd,de->bse', x, w_in) + b_in
    (za, ga, zq, zk, zv, zf, gb, zc, gc, zg) = jnp.split(z, IN_SPLITS, axis=-1)
    gaf = ga.astype(jnp.float32)
    gbf = gb.astype(jnp.float32)
    gcf = gc.astype(jnp.float32)
    y_a = pool_mixer(za, pool_w, pool_scale) * jax.nn.silu(gaf)
    y_b = fox_attention(zq.reshape(b, s, N_HEADS, HEAD_DIM), zk.reshape(b, s, N_HEADS, HEAD_DIM),
                        zv.reshape(b, s, N_HEADS, HEAD_DIM), zf) * jax.nn.silu(gbf)
    y_c = s5_mixer(zc, a_re, a_im, log_dt, b_re, b_im, c_re, c_im, d_skip, w_glu, b_glu) \
        * jax.nn.silu(gcf)
    gates = jax.nn.sigmoid(zg.astype(jnp.float32)).reshape(b, s, N_BRANCHES, D_MODEL)
    merged = (gates[:, :, 0] * jnp.einsum('bsc,cd->bsd', y_a, w_up_a.astype(jnp.float32))
              + gates[:, :, 1] * jnp.einsum('bsc,cd->bsd', y_b, w_up_b.astype(jnp.float32))
              + gates[:, :, 2] * jnp.einsum('bsc,cd->bsd', y_c, w_up_c.astype(jnp.float32)))
    out = jnp.einsum('bsd,de->bse', merged, w_out.astype(jnp.float32))
    return layer_norm((DEEPNORM_ALPHA * x.astype(jnp.float32) + out).astype(x.dtype), ln_g, ln_b)


def setup_inputs(seed: int = 0) -> dict:
    key = jax.random.key(seed)
    ks = jax.random.split(key, 24)
    L = DEPTH
    f32 = jnp.float32
    x = jax.random.normal(ks[0], (BATCH, SEQ, D_MODEL), f32)
    w_in = jax.random.normal(ks[1], (L, D_MODEL, D_IN), f32) * D_MODEL ** -0.5
    b_in = 0.02 * jax.random.normal(ks[2], (L, D_IN), f32)
    f_bias = jnp.linspace(1.0, 5.0, N_HEADS)[None, :] + 0.1 * jax.random.normal(ks[3], (L, N_HEADS), f32)
    b_in = b_in.at[:, F_OFFSET:F_OFFSET + N_HEADS].set(f_bias)
    pool_w = jax.random.normal(ks[4], (L, len(POOL_WINDOWS), POOL_GROUP, POOL_GROUP), f32) * POOL_GROUP ** -0.5
    pool_scale = 1.0 + 0.1 * jax.random.normal(ks[5], (L, D_A), f32)
    n_idx = jnp.arange(SSM_STATE, dtype=f32)[None, None, :]
    ssm_a_re = -0.5 + 0.01 * jax.random.normal(ks[6], (L, SSM_GROUPS, SSM_STATE), f32)
    ssm_a_im = math.pi * n_idx + 0.01 * jax.random.normal(ks[7], (L, SSM_GROUPS, SSM_STATE), f32)
    ssm_log_dt = jax.random.uniform(ks[8], (L, SSM_GROUPS), f32, math.log(DT_MIN), math.log(DT_MAX))
    bs = (2.0 * SSM_GROUP) ** -0.5
    ssm_b_re = jax.random.normal(ks[9], (L, SSM_GROUPS, SSM_STATE, SSM_GROUP), f32) * bs
    ssm_b_im = jax.random.normal(ks[10], (L, SSM_GROUPS, SSM_STATE, SSM_GROUP), f32) * bs
    cs = (2.0 * SSM_STATE) ** -0.5
    ssm_c_re = jax.random.normal(ks[11], (L, SSM_GROUPS, SSM_GROUP, SSM_STATE), f32) * cs
    ssm_c_im = jax.random.normal(ks[12], (L, SSM_GROUPS, SSM_GROUP, SSM_STATE), f32) * cs
    ssm_d = jax.random.normal(ks[13], (L, D_C), f32)
    w_glu = jax.random.normal(ks[14], (L, D_C, D_C), f32) * D_C ** -0.5
    b_glu = 0.02 * jax.random.normal(ks[15], (L, D_C), f32)
    w_up_a = jax.random.normal(ks[16], (L, D_A, D_MODEL), f32) * (D_A ** -0.5) * DEEPNORM_BETA
    w_up_b = jax.random.normal(ks[17], (L, D_B, D_MODEL), f32) * (D_B ** -0.5) * DEEPNORM_BETA
    w_up_c = jax.random.normal(ks[18], (L, D_C, D_MODEL), f32) * (D_C ** -0.5) * DEEPNORM_BETA
    w_out = jax.random.normal(ks[19], (L, D_MODEL, D_MODEL), f32) * (D_MODEL ** -0.5) * DEEPNORM_BETA
    ln_g = 1.0 + 0.05 * jax.random.normal(ks[20], (L, D_MODEL), f32)
    ln_b = 0.02 * jax.random.normal(ks[21], (L, D_MODEL), f32)
    return {"x": x, "w_in": w_in, "b_in": b_in, "pool_w": pool_w, "pool_scale": pool_scale,
            "ssm_a_re": ssm_a_re, "ssm_a_im": ssm_a_im, "ssm_log_dt": ssm_log_dt,
            "ssm_b_re": ssm_b_re, "ssm_b_im": ssm_b_im, "ssm_c_re": ssm_c_re, "ssm_c_im": ssm_c_im,
            "ssm_d": ssm_d, "w_glu": w_glu, "b_glu": b_glu, "w_up_a": w_up_a, "w_up_b": w_up_b,
            "w_up_c": w_up_c, "w_out": w_out, "ln_g": ln_g, "ln_b": ln_b}


def reference(x, w_in, b_in, pool_w, pool_scale, ssm_a_re, ssm_a_im, ssm_log_dt, ssm_b_re, ssm_b_im,
              ssm_c_re, ssm_c_im, ssm_d, w_glu, b_glu, w_up_a, w_up_b, w_up_c, w_out, ln_g, ln_b):
    h = x
    for l in range(DEPTH):
        h = hybrid_layer(h, w_in[l], b_in[l], pool_w[l], pool_scale[l], ssm_a_re[l], ssm_a_im[l],
                         ssm_log_dt[l], ssm_b_re[l], ssm_b_im[l], ssm_c_re[l], ssm_c_im[l], ssm_d[l],
                         w_glu[l], b_glu[l], w_up_a[l], w_up_b[l], w_up_c[l], w_out[l], ln_g[l], ln_b[l])
    return h
```

```cpp
#include <hip/hip_runtime.h>
#include <hip/hip_cooperative_groups.h>
#include <hip/hip_bf16.h>
#include <cstdio>
#include <cstdint>
namespace cg = cooperative_groups;

#ifndef MK_ONE_LAUNCH
#define MK_ONE_LAUNCH 1
#endif

constexpr int MTOK = 32768, DM = 1024, SEQ = 4096, NBATCH = 8, NHEAD = 8, DIN = 6152, NLAYER = 4;
constexpr float LOG2E = 1.4426950408889634f;
constexpr float QSCALE = 0.125f * 1.4426950408889634f;
constexpr float DN_ALPHA = 1.681792830507429f;
constexpr float LN_EPS = 1e-5f;

__device__ __forceinline__ float sigm(float v) { return __builtin_amdgcn_rcpf(1.0f + __builtin_amdgcn_exp2f(-LOG2E * v)); }
__device__ __forceinline__ float bf_lo(unsigned w) { return __uint_as_float(w << 16); }
__device__ __forceinline__ float silu_f(float v) { return v * __builtin_amdgcn_rcpf(1.0f + __builtin_amdgcn_exp2f(-1.4426950408889634f * v)); }
__device__ __forceinline__ float bf_hi(unsigned w) { return __uint_as_float(w & 0xffff0000u); }

namespace pg8 {
#define PG8_LAS __attribute__((address_space(3)))
typedef unsigned short bf16_t;
typedef short bf16x8 __attribute__((ext_vector_type(8)));
typedef float f32x4 __attribute__((ext_vector_type(4)));
typedef unsigned u32x4 __attribute__((ext_vector_type(4)));
constexpr int BM = 256, BK = 64, HALF = 128, HTB = HALF * BK * 2  , STAGE_BYTES = 8 * HTB, NXCD = 8, WGM = 4;

__host__ __device__ __forceinline__ int lds_byte(int r, int c) { const int st = (r >> 4) * 2 + (c >> 5), rr = r & 15, cc = c & 31, ob = rr * 64 + cc * 2; return st * 1024 + (ob ^ (((ob >> 9) & 1) << 5)); }
__host__ __device__ __forceinline__ void stage_rc(int b, int& R, int& C) { const int st = b / 1024, sb = b % 1024, swz = sb ^ (((sb >> 9) & 1) << 5); R = (st >> 1) * 16 + swz / 64; C = (st & 1) * 32 + (swz % 64) / 2; }
__host__ __device__ __forceinline__ int perm32(int rho) { const int n = rho >> 4, i = rho & 15; return 8 * (i >> 2) + 4 * n + (i & 3); }

struct Unit { int pm, pn; };
struct Gemm { const bf16_t* A; const bf16_t* Bt; int M, N, K; };

struct StaticOrder {
    int nM, nN, nwg, G, c;
    __host__ __device__ void init(int M, int N, int G_, int c_) { nM = M / BM; nN = N / BM; nwg = nM * nN; G = G_; c = c_; }
    __host__ __device__ bool next(int i, Unit& u) const {
        const long L = (long)i * G + c; if (L >= nwg) return false;
        int wgid = (int)L; { const int q = nwg / NXCD, r = nwg % NXCD, xcd = wgid % NXCD, off = wgid / NXCD; wgid = (xcd < r ? xcd * (q + 1) : r * (q + 1) + (xcd - r) * q) + off; }
        const int nig = WGM * nN, gid = wgid / nig, fm = gid * WGM, gsz = (nM - fm) < WGM ? (nM - fm) : WGM;
        u.pm = fm + ((wgid % nig) % gsz); u.pn = (wgid % nig) / gsz; return true;
    }
    __device__ __forceinline__ void a_ready(const Unit&) const {}
    __device__ __forceinline__ void done(const Unit&) const {}
};


typedef float f32x2_t __attribute__((ext_vector_type(2))); typedef __bf16 bf16x2_t __attribute__((ext_vector_type(2)));
__device__ __forceinline__ unsigned cvt_pk_bf16(float lo, float hi) { f32x2_t v = {lo, hi}; bf16x2_t b = __builtin_convertvector(v, bf16x2_t); return __builtin_bit_cast(unsigned, b); }

template <int MODE> __device__ __forceinline__ float actf(float v) {
    if (MODE == 1) return v * sigm(v);
    if (MODE == 2) return fminf(1.0f + __builtin_amdgcn_exp2f(-LOG2E * v), 1e30f);
    if (MODE == 3) return v * QSCALE;
    return v;
}
#define EPI_FENCE() asm volatile("" ::: "memory")
#define EPI_LANE() int t__ = threadIdx.x; asm volatile("" : "+v"(t__)); const int wid__ = __builtin_amdgcn_readfirstlane(t__ >> 6); wr = wid__ >> 2; wc = wid__ & 3; fr = t__ & 15; fq = (t__ & 63) >> 4
struct EpiZ {
    static constexpr bool PERM = true, AFTER_DRAIN = false, HOOK = false, ACC_INIT = true;
    bf16_t* O; const float* bias;
    __device__ __forceinline__ void acc_init(f32x4 (&ini)[2][2], const Unit& u) const {
        int t__ = threadIdx.x; asm volatile("" : "+v"(t__)); const int wid__ = __builtin_amdgcn_readfirstlane(t__ >> 6), wc = wid__ & 3, fq = (t__ & 63) >> 4;
        const int pn = u.pn; const float* bp = bias + pn * BM + (pn >= 8 ? 8 : 0) + wc * 32 + 8 * fq;
#pragma unroll
        for (int bj = 0; bj < 2; ++bj)
#pragma unroll
            for (int n = 0; n < 2; ++n) ini[bj][n] = *(const f32x4*)(bp + bj * HALF + 4 * n);
    }
    template <int MODE> __device__ __forceinline__ void run(const f32x4 (&acc)[2][2][4][2], const Unit& u, int wr, int wc, int fr, int fq) const {
        EPI_LANE();
        const int pn = u.pn, colt = pn * BM, t = colt >> 9;
        char* base = (MODE == 2) ? (char*)(O + (size_t)6 * ((size_t)MTOK * 512)) + ((size_t)(((pn - 12) * 128 + u.pm) * 8 + wid__)) * 16384
                                 : (char*)(O + (size_t)t * ((size_t)MTOK * 512) + (size_t)u.pm * BM * 512 + (colt & 511));
        unsigned off0 = (MODE == 2) ? (unsigned)((t__ & 63) * 16) : (unsigned)((wr * 64 + fr) * 512 + wc * 32 + 8 * fq) * 2u; asm volatile("" : "+v"(off0));
#pragma unroll
        for (int bj = 0; bj < 2; ++bj) {
#pragma unroll
            for (int ai = 0; ai < 2; ++ai)
#pragma unroll
                for (int m = 0; m < 4; ++m) { const unsigned off = off0 + ((MODE == 2) ? (unsigned)(((ai * 4 + m) * 2 + bj) * 1024) : (unsigned)((ai * HALF + m * 16) * 512 + bj * HALF) * 2u);
                    const f32x4 v0 = acc[ai][bj][m][0], v1 = acc[ai][bj][m][1];
                    u32x4 w; w.x = cvt_pk_bf16(actf<MODE>(v0[0]), actf<MODE>(v0[1])); w.y = cvt_pk_bf16(actf<MODE>(v0[2]), actf<MODE>(v0[3]));
                    w.z = cvt_pk_bf16(actf<MODE>(v1[0]), actf<MODE>(v1[1])); w.w = cvt_pk_bf16(actf<MODE>(v1[2]), actf<MODE>(v1[3]));
                    *(u32x4*)(base + off) = w; }
            EPI_FENCE();
        }
    }
    __device__ __forceinline__ void operator()(const f32x4 (&acc)[2][2][4][2], const Unit& u, int wr, int wc, int fr, int fq) const {
        const int pn = u.pn;
        if (pn >= 12) run<2>(acc, u, wr, wc, fr, fq);
        else if (pn == 2 || pn == 3) run<3>(acc, u, wr, wc, fr, fq);
        else run<0>(acc, u, wr, wc, fr, fq);
    }
};
struct EpiGlu {
    static constexpr bool PERM = true, AFTER_DRAIN = false, HOOK = false, ACC_INIT = true;
    const bf16_t* YG; const bf16_t* ZC; const float* bias; bf16_t* Y;
    __device__ __forceinline__ void acc_init(f32x4 (&ini)[2][2], const Unit& u) const {
        int t__ = threadIdx.x; asm volatile("" : "+v"(t__)); const int wid__ = __builtin_amdgcn_readfirstlane(t__ >> 6), wc = wid__ & 3, fq = (t__ & 63) >> 4;
        const float* bp = bias + wc * 32 + 8 * fq; (void)u;
#pragma unroll
        for (int bj = 0; bj < 2; ++bj)
#pragma unroll
            for (int n = 0; n < 2; ++n) ini[bj][n] = *(const f32x4*)(bp + bj * HALF + 4 * n);
    }
    __device__ __forceinline__ void operator()(const f32x4 (&acc)[2][2][4][2], const Unit& u, int wr, int wc, int fr, int fq) const {
        EPI_LANE();
        const char* ygb = (const char*)(YG + (size_t)u.pm * BM * 256); const char* sgb = (const char*)(ZC + (size_t)u.pm * BM * 512 + 256); char* yb = (char*)(Y + (size_t)u.pm * BM * 1024 + 768);
        unsigned rl0 = (unsigned)(wr * 64 + fr), col0 = (unsigned)(wc * 32 + 8 * fq); asm volatile("" : "+v"(rl0), "+v"(col0));
#pragma unroll
        for (int bj = 0; bj < 2; ++bj) { const unsigned col = col0 + bj * HALF;
#pragma unroll
            for (int ai = 0; ai < 2; ++ai) {
                u32x4 ygv[4], sgv[4];
#pragma unroll
                for (int m = 0; m < 4; ++m) { const unsigned rl = rl0 + (unsigned)(ai * HALF + m * 16);
                    ygv[m] = *(const u32x4*)(ygb + (rl * 256u + col) * 2u); sgv[m] = *(const u32x4*)(sgb + (rl * 512u + col) * 2u); }
#pragma unroll
                for (int m = 0; m < 4; ++m) { const unsigned rl = rl0 + (unsigned)(ai * HALF + m * 16);
                    const u32x4 yg = ygv[m], sg = sgv[m];
                    const f32x4 v0 = acc[ai][bj][m][0], v1 = acc[ai][bj][m][1];
                    u32x4 w;
                    w.x = cvt_pk_bf16(bf_lo(yg.x) * sigm(v0[0]) * silu_f(bf_lo(sg.x)), bf_hi(yg.x) * sigm(v0[1]) * silu_f(bf_hi(sg.x)));
                    w.y = cvt_pk_bf16(bf_lo(yg.y) * sigm(v0[2]) * silu_f(bf_lo(sg.y)), bf_hi(yg.y) * sigm(v0[3]) * silu_f(bf_hi(sg.y)));
                    w.z = cvt_pk_bf16(bf_lo(yg.z) * sigm(v1[0]) * silu_f(bf_lo(sg.z)), bf_hi(yg.z) * sigm(v1[1]) * silu_f(bf_hi(sg.z)));
                    w.w = cvt_pk_bf16(bf_lo(yg.w) * sigm(v1[2]) * silu_f(bf_lo(sg.w)), bf_hi(yg.w) * sigm(v1[3]) * silu_f(bf_hi(sg.w)));
                    *(u32x4*)(yb + (rl * 1024u + col) * 2u) = w; }
                asm volatile("" : "+v"(rl0), "+v"(col0) :: "memory"); } }
    }
};
struct EpiUp {
    static constexpr bool PERM = true, AFTER_DRAIN = false, HOOK = true, ACC_INIT = false;
    const bf16_t* G; bf16_t* Mg;
    __device__ __forceinline__ const char* gbase(int br, const Unit& u, int wid) const { return (const char*)G + ((size_t)(((br * 4 + u.pn) * 128 + u.pm) * 8 + wid)) * 16384; }
    __device__ __forceinline__ void hook(f32x4 (&acc)[2][2][4][2], const Unit& u, int which, int wr, int wc, int fr, int fq) const {
        EPI_LANE();
        const char* gn_b = gbase(which, u, wid__); const char* gd_b = gbase(which + 1, u, wid__);
        unsigned off0 = (unsigned)((t__ & 63) * 16); asm volatile("" : "+v"(off0));
#pragma unroll
        for (int ai = 0; ai < 2; ++ai) {
                u32x4 gnv[4][2], gdv[4][2];
#pragma unroll
                for (int m = 0; m < 4; ++m)
#pragma unroll
                    for (int bj = 0; bj < 2; ++bj) { const unsigned off = off0 + (unsigned)(((ai * 4 + m) * 2 + bj) * 1024);
                        gnv[m][bj] = *(const u32x4*)(gn_b + off); gdv[m][bj] = *(const u32x4*)(gd_b + off); }
#pragma unroll
                for (int m = 0; m < 4; ++m)
#pragma unroll
                    for (int bj = 0; bj < 2; ++bj) { const u32x4 gn = gnv[m][bj], gd = gdv[m][bj];
#define RT(a, b) ((b) * __builtin_amdgcn_rcpf(a))
                        f32x4 r0, r1;
                        r0[0] = RT(bf_lo(gn.x), bf_lo(gd.x)); r0[1] = RT(bf_hi(gn.x), bf_hi(gd.x)); r0[2] = RT(bf_lo(gn.y), bf_lo(gd.y)); r0[3] = RT(bf_hi(gn.y), bf_hi(gd.y));
                        r1[0] = RT(bf_lo(gn.z), bf_lo(gd.z)); r1[1] = RT(bf_hi(gn.z), bf_hi(gd.z)); r1[2] = RT(bf_lo(gn.w), bf_lo(gd.w)); r1[3] = RT(bf_hi(gn.w), bf_hi(gd.w));
#undef RT
                        acc[ai][bj][m][0] *= r0; acc[ai][bj][m][1] *= r1; }
                asm volatile("" : "+v"(off0) :: "memory"); }
    }
    __device__ __forceinline__ void operator()(const f32x4 (&acc)[2][2][4][2], const Unit& u, int wr, int wc, int fr, int fq) const {
        EPI_LANE();
        const char* g_b = gbase(2, u, wid__) + (t__ & 63) * 16; char* mb = (char*)(Mg + (size_t)u.pm * BM * 1024 + u.pn * BM);
        unsigned rl0 = (unsigned)(wr * 64 + fr), cl0 = (unsigned)(wc * 32 + 8 * fq); asm volatile("" : "+v"(rl0), "+v"(cl0));
#pragma unroll
        for (int ai = 0; ai < 2; ++ai) {
            u32x4 gv[4][2];
#pragma unroll
            for (int m = 0; m < 4; ++m)
#pragma unroll
                for (int bj = 0; bj < 2; ++bj) gv[m][bj] = *(const u32x4*)(g_b + ((ai * 4 + m) * 2 + bj) * 1024);
#pragma unroll
            for (int m = 0; m < 4; ++m) { const unsigned rl = rl0 + (unsigned)(ai * HALF + m * 16);
#pragma unroll
                for (int bj = 0; bj < 2; ++bj) { const unsigned cl = cl0 + (unsigned)(bj * HALF);
                    const u32x4 g = gv[m][bj];
                    const f32x4 v0 = acc[ai][bj][m][0], v1 = acc[ai][bj][m][1];
                    u32x4 w;
                    w.x = cvt_pk_bf16(v0[0] * __builtin_amdgcn_rcpf(bf_lo(g.x)), v0[1] * __builtin_amdgcn_rcpf(bf_hi(g.x)));
                    w.y = cvt_pk_bf16(v0[2] * __builtin_amdgcn_rcpf(bf_lo(g.y)), v0[3] * __builtin_amdgcn_rcpf(bf_hi(g.y)));
                    w.z = cvt_pk_bf16(v1[0] * __builtin_amdgcn_rcpf(bf_lo(g.z)), v1[1] * __builtin_amdgcn_rcpf(bf_hi(g.z)));
                    w.w = cvt_pk_bf16(v1[2] * __builtin_amdgcn_rcpf(bf_lo(g.w)), v1[3] * __builtin_amdgcn_rcpf(bf_hi(g.w)));
                    *(u32x4*)(mb + (rl * 1024u + cl) * 2u) = w; } }
            asm volatile("" : "+v"(rl0), "+v"(cl0) :: "memory"); }
    }
};
struct EpiOut {
    static constexpr bool PERM = false, AFTER_DRAIN = false, HOOK = false, ACC_INIT = false;
    const float* base; float* out; const float* stats; const float* lng; const float* lnb;
    __device__ __forceinline__ void operator()(const f32x4 (&acc)[2][2][4][2], const Unit& u, int wr, int wc, int fr, int fq) const {
        EPI_LANE();
        const size_t tile = (size_t)u.pm * BM * 1024 + u.pn * BM;
        const char* bb = (const char*)(base + tile); char* ob = (char*)(out + tile);
        unsigned off0 = (unsigned)((wr * 64 + fr) * 1024 + wc * 32 + 4 * fq) * 4u; asm volatile("" : "+v"(off0));
        if (stats == nullptr) {
#pragma unroll
            for (int ai = 0; ai < 2; ++ai) {
                f32x4 bs[4][2][2];
#pragma unroll
                for (int m = 0; m < 4; ++m)
#pragma unroll
                    for (int bj = 0; bj < 2; ++bj)
#pragma unroll
                        for (int n = 0; n < 2; ++n) bs[m][bj][n] = *(const f32x4*)(bb + off0 + (unsigned)((ai * HALF + m * 16) * 1024 + bj * HALF + n * 16) * 4u);
#pragma unroll
                for (int m = 0; m < 4; ++m)
#pragma unroll
                    for (int bj = 0; bj < 2; ++bj)
#pragma unroll
                        for (int n = 0; n < 2; ++n) *(f32x4*)(ob + off0 + (unsigned)((ai * HALF + m * 16) * 1024 + bj * HALF + n * 16) * 4u) = bs[m][bj][n] * DN_ALPHA + acc[ai][bj][m][n];
                asm volatile("" : "+v"(off0) :: "memory"); }
        } else {
            const char* sp = (const char*)(stats + (size_t)u.pm * BM * 2);
            unsigned soff0 = (unsigned)(wr * 64 + fr) * 8u, coff0 = (unsigned)(u.pn * BM + wc * 32 + 4 * fq) * 4u; asm volatile("" : "+v"(soff0), "+v"(coff0));
            f32x4 gv[2][2], bv[2][2];
#pragma unroll
            for (int bj = 0; bj < 2; ++bj)
#pragma unroll
                for (int n = 0; n < 2; ++n) { gv[bj][n] = *(const f32x4*)((const char*)lng + coff0 + (unsigned)(bj * HALF + n * 16) * 4u); bv[bj][n] = *(const f32x4*)((const char*)lnb + coff0 + (unsigned)(bj * HALF + n * 16) * 4u); }
#pragma unroll
            for (int ai = 0; ai < 2; ++ai)
#pragma unroll
                for (int mh = 0; mh < 2; ++mh) {
                    f32x4 bs[2][2][2]; f32x2_t st[2];
#pragma unroll
                    for (int mm = 0; mm < 2; ++mm) { st[mm] = *(const f32x2_t*)(sp + soff0 + (unsigned)(ai * HALF + (2 * mh + mm) * 16) * 8u);
#pragma unroll
                        for (int bj = 0; bj < 2; ++bj)
#pragma unroll
                            for (int n = 0; n < 2; ++n) bs[mm][bj][n] = *(const f32x4*)(bb + off0 + (unsigned)((ai * HALF + (2 * mh + mm) * 16) * 1024 + bj * HALF + n * 16) * 4u); }
#pragma unroll
                    for (int mm = 0; mm < 2; ++mm)
#pragma unroll
                        for (int bj = 0; bj < 2; ++bj)
#pragma unroll
                            for (int n = 0; n < 2; ++n) { const f32x4 hv = ((bs[mm][bj][n] - st[mm][0]) * st[mm][1]) * gv[bj][n] + bv[bj][n];
                                *(f32x4*)(ob + off0 + (unsigned)((ai * HALF + (2 * mh + mm) * 16) * 1024 + bj * HALF + n * 16) * 4u) = hv * DN_ALPHA + acc[ai][bj][2 * mh + mm][n]; }
                    asm volatile("" : "+v"(off0), "+v"(soff0) :: "memory"); }
        }
    }
};

template <class Epi, class Sched, bool ALIGN_EPI = false, bool SP2 = false>
__device__ __forceinline__ void gemm_phase(PG8_LAS unsigned char* lds, const Gemm g, const Sched& S, const Epi& E) {
    int tid_ = threadIdx.x; asm volatile("" : "+v"(tid_));
    const int tid = tid_, wid = __builtin_amdgcn_readfirstlane(tid >> 6), lane = tid & 63, wr = wid >> 2, wc = wid & 3, fr = lane & 15, fq = lane >> 4;
    int K_ = g.K; asm volatile("" : "+s"(K_));
    const int K = K_, nt = K / BK;
    unsigned voffA[2], voffB[2];
#pragma unroll
    for (int i = 0; i < 2; ++i) { int R, C; stage_rc(tid * 16 + i * 8192, R, C); const int Rb = Epi::PERM ? ((R & ~31) + perm32(R & 31)) : R;
        voffA[i] = (unsigned)(R * K + C) * 2u; voffB[i] = (unsigned)(Rb * K + C) * 2u; }
    const size_t kstep = (size_t)(BK * 2);
    const size_t hstep = (size_t)HALF * K * 2;
    const size_t tstep = 2 * hstep;
    const unsigned ldsw = (unsigned)wid * 1024u;
    const int aoff = lds_byte(wr * 64 + fr, fq * 8), boff = lds_byte(wc * 32 + fr, fq * 8);
#define PG8_SA(b, h) (((b) * 2 + (h)) * HTB)
#define PG8_SB(b, h) ((4 + (b) * 2 + (h)) * HTB)
#define PG8_STAGE(bufoff, gbase, voff) do { _Pragma("unroll") for (int _i = 0; _i < 2; ++_i) \
        __builtin_amdgcn_global_load_lds((const unsigned*)((const char*)(gbase) + (voff)[_i]), (PG8_LAS unsigned*)(lds + (bufoff) + ldsw + _i * 8192), 16, 0, 0); } while (0)
#define PG8_LDA(dst, b, h) do { _Pragma("unroll") for (int m = 0; m < 4; ++m) _Pragma("unroll") for (int k = 0; k < 2; ++k) dst[m][k] = *(const PG8_LAS bf16x8*)(lds + PG8_SA(b, h) + aoff + m * 2048 + k * 1024); } while (0)
#define PG8_LDB(dst, b, h) do { _Pragma("unroll") for (int n = 0; n < 2; ++n) _Pragma("unroll") for (int k = 0; k < 2; ++k) dst[n][k] = *(const PG8_LAS bf16x8*)(lds + PG8_SB(b, h) + boff + n * 2048 + k * 1024); } while (0)
#define PG8_MMA(ai, bj, At, Bt) do { __builtin_amdgcn_s_setprio(1); _Pragma("unroll") for (int m = 0; m < 4; ++m) _Pragma("unroll") for (int n = 0; n < 2; ++n) _Pragma("unroll") for (int k = 0; k < 2; ++k) \
        acc[ai][bj][m][n] = __builtin_amdgcn_mfma_f32_16x16x32_bf16(Bt[n][k], At[m][k], acc[ai][bj][m][n], 0, 0, 0); __builtin_amdgcn_s_setprio(0); } while (0)
#define PG8_WAIT_V(n) asm volatile("s_waitcnt vmcnt(" #n ")" ::: "memory")
#define PG8_WAIT_L(n) asm volatile("s_waitcnt lgkmcnt(" #n ")" ::: "memory")
#define PG8_BAR __builtin_amdgcn_s_barrier()
#define PG8_SCHED __builtin_amdgcn_sched_barrier(0)
    Unit cur, nxt; int ui = 0;
    if (!S.next(0, cur)) return;
    f32x4 acc[2][2][4][2];
    f32x4 ini[2][2];
#pragma unroll
    for (int b = 0; b < 2; ++b)
#pragma unroll
        for (int n = 0; n < 2; ++n) ini[b][n] = (f32x4){0.f, 0.f, 0.f, 0.f};
    if constexpr (Epi::ACC_INIT) E.acc_init(ini, cur);
#pragma unroll
    for (int a = 0; a < 2; ++a)
#pragma unroll
        for (int b = 0; b < 2; ++b)
#pragma unroll
            for (int m = 0; m < 4; ++m)
#pragma unroll
                for (int n = 0; n < 2; ++n) acc[a][b][m][n] = ini[b][n];
    bf16x8 At[4][2], B0[2][2], B1[2][2];
    const char* cA = (const char*)g.A + (size_t)cur.pm * tstep; const char* cB = (const char*)g.Bt + (size_t)cur.pn * tstep;
    S.a_ready(cur);
    if constexpr (SP2) {
        PG8_STAGE(PG8_SB(0, 0), cB, voffB); PG8_STAGE(PG8_SB(0, 1), cB + hstep, voffB); PG8_STAGE(PG8_SA(0, 0), cA, voffA); PG8_STAGE(PG8_SA(0, 1), cA + hstep, voffA);
        if (wr == 1) PG8_BAR;
        PG8_WAIT_V(2); PG8_BAR;
        PG8_STAGE(PG8_SB(1, 0), cB + kstep, voffB); PG8_STAGE(PG8_SA(1, 0), cA + kstep, voffA); PG8_STAGE(PG8_SB(1, 1), cB + hstep + kstep, voffB);
        PG8_WAIT_V(6); PG8_BAR;
    } else {
        PG8_STAGE(PG8_SB(0, 0), cB, voffB); PG8_STAGE(PG8_SA(0, 0), cA, voffA); PG8_STAGE(PG8_SB(0, 1), cB + hstep, voffB); PG8_STAGE(PG8_SA(0, 1), cA + hstep, voffA);
        if (wr == 1) PG8_BAR;
        PG8_WAIT_V(4); PG8_BAR;
        PG8_STAGE(PG8_SB(1, 0), cB + kstep, voffB); PG8_STAGE(PG8_SA(1, 0), cA + kstep, voffA); PG8_STAGE(PG8_SB(1, 1), cB + hstep + kstep, voffB);
        PG8_WAIT_V(6); PG8_BAR;
    }
    for (;;) {
        const bool has_next = S.next(ui + 1, nxt);
        const char* nA = has_next ? (const char*)g.A + (size_t)nxt.pm * tstep : cA; const char* nB = has_next ? (const char*)g.Bt + (size_t)nxt.pn * tstep : cB;
        for (int t = 0; t < nt; t += 2) {
            if constexpr (Epi::HOOK) { if (t == 4 || t == 12) { PG8_SCHED; E.hook(acc, cur, t == 4 ? 0 : 1, wr, wc, fr, fq); asm volatile("" ::: "memory"); PG8_SCHED; } }
            const bool last = (t == nt - 2);
            const char* a1 = cA + (size_t)(t + 1) * kstep;
            const char* a2 = last ? nA : cA + (size_t)(t + 2) * kstep; const char* b2 = last ? nB : cB + (size_t)(t + 2) * kstep;
            const char* a3 = a2 + kstep; const char* b3 = b2 + kstep;
            if (last && has_next) S.a_ready(nxt);
            if constexpr (SP2) {
            PG8_LDB(B0, 0, 0); PG8_LDB(B1, 0, 1); PG8_SCHED; PG8_LDA(At, 0, 0); PG8_STAGE(PG8_SA(1, 1), a1 + hstep, voffA);
            PG8_WAIT_V(8); PG8_WAIT_L(0); PG8_BAR; PG8_MMA(0, 0, At, B0); PG8_MMA(0, 1, At, B1); PG8_BAR; PG8_SCHED;
            PG8_LDA(At, 0, 1); PG8_STAGE(PG8_SB(0, 0), b2, voffB); PG8_STAGE(PG8_SB(0, 1), b2 + hstep, voffB); PG8_STAGE(PG8_SA(0, 0), a2, voffA);
            PG8_WAIT_V(8); PG8_WAIT_L(0); PG8_BAR; PG8_MMA(1, 0, At, B0); PG8_MMA(1, 1, At, B1); PG8_BAR; PG8_SCHED;
            PG8_LDB(B0, 1, 0); PG8_LDB(B1, 1, 1); PG8_SCHED; PG8_LDA(At, 1, 0); PG8_STAGE(PG8_SA(0, 1), a2 + hstep, voffA);
            PG8_WAIT_V(8); PG8_WAIT_L(0); PG8_BAR; PG8_MMA(0, 0, At, B0); PG8_MMA(0, 1, At, B1); PG8_BAR; PG8_SCHED;
            PG8_LDA(At, 1, 1); PG8_STAGE(PG8_SB(1, 0), b3, voffB); PG8_STAGE(PG8_SB(1, 1), b3 + hstep, voffB); PG8_STAGE(PG8_SA(1, 0), a3, voffA);
            PG8_WAIT_V(8); PG8_WAIT_L(0); PG8_BAR; PG8_MMA(1, 0, At, B0); PG8_MMA(1, 1, At, B1); PG8_BAR; PG8_SCHED;
            } else {
            PG8_LDB(B0, 0, 0); PG8_SCHED; PG8_LDA(At, 0, 0); PG8_STAGE(PG8_SA(1, 1), a1 + hstep, voffA);
            PG8_WAIT_L(8); PG8_BAR; PG8_WAIT_L(0); PG8_MMA(0, 0, At, B0); PG8_BAR; PG8_SCHED;
            PG8_LDB(B1, 0, 1); PG8_STAGE(PG8_SB(0, 0), b2, voffB);
            PG8_BAR; PG8_WAIT_L(0); PG8_MMA(0, 1, At, B1); PG8_BAR;
            PG8_LDA(At, 0, 1); PG8_STAGE(PG8_SA(0, 0), a2, voffA);
            PG8_BAR; PG8_WAIT_L(0); PG8_MMA(1, 0, At, B0); PG8_BAR; PG8_SCHED;
            PG8_STAGE(PG8_SB(0, 1), b2 + hstep, voffB);
            PG8_WAIT_V(6); PG8_BAR; PG8_MMA(1, 1, At, B1); PG8_BAR;
            PG8_LDB(B0, 1, 0); PG8_SCHED; PG8_LDA(At, 1, 0); PG8_STAGE(PG8_SA(0, 1), a2 + hstep, voffA);
            PG8_WAIT_L(8); PG8_BAR; PG8_WAIT_L(0); PG8_MMA(0, 0, At, B0); PG8_BAR; PG8_SCHED;
            PG8_LDB(B1, 1, 1); PG8_STAGE(PG8_SB(1, 0), b3, voffB);
            PG8_BAR; PG8_WAIT_L(0); PG8_MMA(0, 1, At, B1); PG8_BAR;
            PG8_LDA(At, 1, 1); PG8_STAGE(PG8_SA(1, 0), a3, voffA);
            PG8_BAR; PG8_WAIT_L(0); PG8_MMA(1, 0, At, B0); PG8_BAR; PG8_SCHED;
            PG8_STAGE(PG8_SB(1, 1), b3 + hstep, voffB);
            PG8_WAIT_V(6); PG8_BAR; PG8_MMA(1, 1, At, B1); PG8_BAR;
            }
        }
        if constexpr (ALIGN_EPI) { if (wr == 0) PG8_BAR; }
        if constexpr (!Epi::AFTER_DRAIN) { E(acc, cur, wr, wc, fr, fq); S.done(cur); }
        if (!has_next) break;
        if constexpr (Epi::ACC_INIT) E.acc_init(ini, nxt);
#pragma unroll
        for (int a = 0; a < 2; ++a)
#pragma unroll
            for (int b = 0; b < 2; ++b)
#pragma unroll
                for (int m = 0; m < 4; ++m)
#pragma unroll
                    for (int n = 0; n < 2; ++n) acc[a][b][m][n] = ini[b][n];
        cur = nxt; cA = nA; cB = nB; ++ui;
        if constexpr (ALIGN_EPI) { if (wr == 1) PG8_BAR; }
    }
    PG8_WAIT_V(0);
    if constexpr (!ALIGN_EPI) { if (wr == 0) PG8_BAR; }
    PG8_BAR;
    if constexpr (Epi::AFTER_DRAIN) { E.fused(acc, cur, wr, wc, fr, fq, lds, wid, lane); S.done(cur); }
#undef PG8_SA
#undef PG8_SB
#undef PG8_STAGE
#undef PG8_LDA
#undef PG8_LDB
#undef PG8_MMA
#undef PG8_WAIT_V
#undef PG8_WAIT_L
#undef PG8_BAR
#undef PG8_SCHED
}
}

constexpr size_t MiB = 1u << 20;
constexpr size_t WS_FLOG = 1 * MiB;
constexpr size_t WS_FCUM = 2 * MiB;
constexpr size_t WS_NORM = 14336;
constexpr size_t WS_SEND = 3 * MiB;
constexpr size_t WS_STATS = 4 * MiB;
constexpr size_t WS_WIN = 8 * MiB;
constexpr size_t WS_WUP = 20 * MiB;
constexpr size_t WS_WOUT = 22 * MiB;
constexpr size_t WS_WGLU = 24 * MiB;
constexpr size_t WS_Z = 32 * MiB;
constexpr size_t ZARR = 32 * MiB;
constexpr size_t WS_XB = 416 * MiB;
constexpr size_t WS_END = 480 * MiB;
constexpr int LDS_BYTES = 147456;

typedef unsigned short bf16_t;
typedef float f32x4 __attribute__((ext_vector_type(4)));
typedef float f32x16 __attribute__((ext_vector_type(16)));
typedef unsigned u32x4 __attribute__((ext_vector_type(4)));
typedef unsigned u32x2 __attribute__((ext_vector_type(2)));
typedef short bf16x8 __attribute__((ext_vector_type(8)));
typedef short s16x4 __attribute__((ext_vector_type(4)));

struct Args { const float* in[21]; float* out; unsigned char* ws; int ph_lo, ph_hi; };
struct Ctx {
    const Args* a; int zero; float* out; unsigned char* ws; unsigned char* lds;
    int tid, lane, wave, vcu, G;
    __device__ __forceinline__ const float* inp(int i) const { return a->in[i + zero]; }
};
#define IN_X 0
#define IN_WIN 1
#define IN_BIN 2
#define IN_POOLW 3
#define IN_POOLS 4
#define IN_ARE 5
#define IN_AIM 6
#define IN_LOGDT 7
#define IN_BRE 8
#define IN_BIM 9
#define IN_CRE 10
#define IN_CIM 11
#define IN_DSKIP 12
#define IN_WGLU 13
#define IN_BGLU 14
#define IN_WUPA 15
#define IN_WUPB 16
#define IN_WUPC 17
#define IN_WOUT 18
#define IN_LNG 19
#define IN_LNB 20

__device__ __forceinline__ unsigned pk_bf16(float lo, float hi) { return pg8::cvt_pk_bf16(lo, hi); }
__device__ __forceinline__ float wave_sum(float v) {
    v += __int_as_float(__builtin_amdgcn_update_dpp(0, __float_as_int(v), 0xB1, 0xf, 0xf, true));
    v += __int_as_float(__builtin_amdgcn_update_dpp(0, __float_as_int(v), 0x4E, 0xf, 0xf, true));
    v += __int_as_float(__builtin_amdgcn_update_dpp(0, __float_as_int(v), 0x141, 0xf, 0xf, true));
    v += __int_as_float(__builtin_amdgcn_update_dpp(0, __float_as_int(v), 0x140, 0xf, 0xf, true));
    const int iv = __float_as_int(v);
    const float r0 = __int_as_float(__builtin_amdgcn_readlane(iv, 0)), r1 = __int_as_float(__builtin_amdgcn_readlane(iv, 16)), r2 = __int_as_float(__builtin_amdgcn_readlane(iv, 32)), r3 = __int_as_float(__builtin_amdgcn_readlane(iv, 48));
    return (r0 + r1) + (r2 + r3);
}
#define LDS_FENCE() asm volatile("s_waitcnt lgkmcnt(0)" ::: "memory")

__device__ __forceinline__ void transpose_item(const float* Wsrc, int ldw, bf16_t* WT, int ldt, int kb, int nb, float* scr, int lane) {
    const int k0 = 64 * kb, n0 = 32 * nb;
#pragma unroll
    for (int i = 0; i < 8; ++i) { const int kk = 8 * i + (lane >> 3), n4 = 4 * (lane & 7);
        const f32x4 v = *(const f32x4*)(Wsrc + (size_t)(k0 + kk) * ldw + n0 + n4);
        scr[kk * 33 + n4] = v[0]; scr[kk * 33 + n4 + 1] = v[1]; scr[kk * 33 + n4 + 2] = v[2]; scr[kk * 33 + n4 + 3] = v[3]; }
    LDS_FENCE();
    const int c = lane & 7;
#pragma unroll
    for (int j = 0; j < 4; ++j) { const int n = (lane >> 3) + 8 * j; const float* s = scr + (8 * c) * 33 + n;
        u32x4 o; o.x = pk_bf16(s[0 * 33], s[1 * 33]); o.y = pk_bf16(s[2 * 33], s[3 * 33]); o.z = pk_bf16(s[4 * 33], s[5 * 33]); o.w = pk_bf16(s[6 * 33], s[7 * 33]);
        *(u32x4*)(WT + (size_t)(n0 + n) * ldt + k0 + 8 * c) = o; }
    LDS_FENCE();
}
__device__ __forceinline__ void phase_rows(const Ctx& c, int l) {
    const int gw = c.vcu * 8 + c.wave, NGW = c.G * 8, lane = c.lane;
    if (l < NLAYER) {
        float* scr = (float*)(c.lds + c.wave * 16384);
        bf16_t* Win_t = (bf16_t*)(c.ws + WS_WIN); bf16_t* Wup_t = (bf16_t*)(c.ws + WS_WUP); bf16_t* Wout_t = (bf16_t*)(c.ws + WS_WOUT); bf16_t* Wglu_t = (bf16_t*)(c.ws + WS_WGLU);
        constexpr int I_IN = 16 * 192, I_A = 4 * 32, I_B = 8 * 32, I_C = 4 * 32, I_O = 16 * 32, I_G = 4 * 8;
        constexpr int NITEMS = I_IN + I_A + I_B + I_C + I_O + I_G;
        for (int it = gw; it < NITEMS; it += NGW) {
            int r = it;
            if (r < I_IN) { const int kb = r / 192, nb = r % 192; const float* src = c.inp(IN_WIN) + (size_t)l * 1024 * DIN + (nb >= 64 ? 8 : 0);
                transpose_item(src, DIN, Win_t, 1024, kb, nb, scr, lane); continue; } r -= I_IN;
            if (r < I_A) { transpose_item(c.inp(IN_WUPA) + (size_t)l * 256 * 1024, 1024, Wup_t, 1024, r / 32, r % 32, scr, lane); continue; } r -= I_A;
            if (r < I_B) { transpose_item(c.inp(IN_WUPB) + (size_t)l * 512 * 1024, 1024, Wup_t + 256, 1024, r / 32, r % 32, scr, lane); continue; } r -= I_B;
            if (r < I_C) { transpose_item(c.inp(IN_WUPC) + (size_t)l * 256 * 1024, 1024, Wup_t + 768, 1024, r / 32, r % 32, scr, lane); continue; } r -= I_C;
            if (r < I_O) { transpose_item(c.inp(IN_WOUT) + (size_t)l * 1024 * 1024, 1024, Wout_t, 1024, r / 32, r % 32, scr, lane); continue; } r -= I_O;
            transpose_item(c.inp(IN_WGLU) + (size_t)l * 256 * 256, 256, Wglu_t, 256, r / 8, r % 8, scr, lane);
        }
    }
    f32x4 wf[16][2];
    float bfv[8];
    if (l < NLAYER) {
        const float* wp = c.inp(IN_WIN) + (size_t)l * 1024 * DIN + 2048;
#pragma unroll
        for (int j = 0; j < 4; ++j)
#pragma unroll
            for (int i = 0; i < 4; ++i) { const float* q = wp + (size_t)(256 * j + 4 * lane + i) * DIN; wf[4 * j + i][0] = *(const f32x4*)q; wf[4 * j + i][1] = *(const f32x4*)(q + 4); }
#pragma unroll
        for (int h = 0; h < 8; ++h) bfv[h] = c.inp(IN_BIN)[(size_t)l * DIN + 2048 + h];
    }
    const float* src = (l == 0) ? c.inp(IN_X) : c.out;
    bf16_t* XB = (bf16_t*)(c.ws + WS_XB);
    float* flog = (float*)(c.ws + WS_FLOG);
    for (int m0 = gw; m0 < MTOK; m0 += 2 * NGW) {
        f32x4 v[2][4];
#pragma unroll
        for (int q = 0; q < 2; ++q) { const int mr = min(m0 + q * NGW, MTOK - 1); const f32x4* xr = (const f32x4*)(src + (size_t)mr * DM) + lane;
#pragma unroll
            for (int j = 0; j < 4; ++j) v[q][j] = xr[64 * j]; }
#pragma unroll
        for (int q = 0; q < 2; ++q) {
        const int m = m0 + q * NGW;
        if (m >= MTOK) continue;
        if (l > 0) {
            float s = 0.f;
#pragma unroll
            for (int j = 0; j < 4; ++j) s += (v[q][j].x + v[q][j].y) + (v[q][j].z + v[q][j].w);
            const float mean = wave_sum(s) * (1.f / DM); float s2 = 0.f;
#pragma unroll
            for (int j = 0; j < 4; ++j) { v[q][j] = v[q][j] - mean; s2 += (v[q][j].x * v[q][j].x + v[q][j].y * v[q][j].y) + (v[q][j].z * v[q][j].z + v[q][j].w * v[q][j].w); }
            const float rstd = 1.f / sqrtf(wave_sum(s2) * (1.f / DM) + LN_EPS);
            const f32x4* gp = (const f32x4*)(c.inp(IN_LNG) + (size_t)(l - 1) * DM) + lane; const f32x4* bp = (const f32x4*)(c.inp(IN_LNB) + (size_t)(l - 1) * DM) + lane;
            f32x4* orow = (f32x4*)(c.out + (size_t)m * DM) + lane;
#pragma unroll
            for (int j = 0; j < 4; ++j) { v[q][j] = v[q][j] * rstd * gp[64 * j] + bp[64 * j]; if (l == NLAYER) orow[64 * j] = v[q][j]; }
            if (l < NLAYER && lane == 0) *(float2*)((float*)(c.ws + WS_STATS) + (size_t)m * 2) = make_float2(mean, rstd);
        }
        if (l < NLAYER) {
            u32x2* o8 = (u32x2*)(XB + (size_t)m * DM) + lane;
#pragma unroll
            for (int j = 0; j < 4; ++j) { u32x2 w; w.x = pk_bf16(v[q][j].x, v[q][j].y); w.y = pk_bf16(v[q][j].z, v[q][j].w); o8[64 * j] = w; }
            f32x4 a0 = {0.f, 0.f, 0.f, 0.f}, a1 = {0.f, 0.f, 0.f, 0.f};
#pragma unroll
            for (int j = 0; j < 4; ++j)
#pragma unroll
                for (int i = 0; i < 4; ++i) { const float xv = v[q][j][i]; a0 += wf[4 * j + i][0] * xv; a1 += wf[4 * j + i][1] * xv; }
            float f[8];
#pragma unroll
            for (int h = 0; h < 4; ++h) { f[h] = wave_sum(a0[h]) + bfv[h]; f[4 + h] = wave_sum(a1[h]) + bfv[4 + h]; }
            if (lane == 0) { *(f32x4*)(flog + (size_t)m * 8) = (f32x4){f[0], f[1], f[2], f[3]}; *(f32x4*)(flog + (size_t)m * 8 + 4) = (f32x4){f[4], f[5], f[6], f[7]}; }
        }
        }
    }
}

__device__ __forceinline__ void fcum_unit(const Ctx& c, int bh) {
    const int b = bh >> 3, h = bh & 7, tid = c.tid;
    const float* flog = (const float*)(c.ws + WS_FLOG);
    float* fcum = (float*)(c.ws + WS_FCUM);
    double* wtot = (double*)(c.lds);
    double loc[8]; double run = 0.0;
#pragma unroll
    for (int i = 0; i < 8; ++i) { const float f = flog[((size_t)b * SEQ + 8 * tid + i) * 8 + h]; const float ls = fminf(f, 0.f) - log1pf(expf(-fabsf(f))); run += (double)ls; loc[i] = run; }
    double incl = run;
#pragma unroll
    for (int o = 1; o < 64; o <<= 1) { const double t = __shfl_up(incl, o); if (c.lane >= o) incl += t; }
    if (c.lane == 63) wtot[c.wave] = incl;
    __syncthreads();
    double base = incl - run;
    for (int w = 0; w < c.wave; ++w) base += wtot[w];
#pragma unroll
    for (int i = 0; i < 8; ++i) fcum[(size_t)bh * SEQ + 8 * tid + i] = (float)((base + loc[i]) * 1.4426950408889634);
    __syncthreads();
}

__device__ __forceinline__ void norm_unit(const Ctx& c, int l, int tile) {
    const int tid = c.tid, tok = tile * 128 + (tid >> 2), part = tid & 3, b = tile >> 5;
    const bf16_t* Q = (const bf16_t*)(c.ws + WS_Z + 1 * ZARR); const bf16_t* K = (const bf16_t*)(c.ws + WS_Z + 2 * ZARR);
    unsigned* nrm = (unsigned*)(c.ws + WS_NORM) + (size_t)l * 128;
    float res[4];
#pragma unroll
    for (int a = 0; a < 2; ++a)
#pragma unroll
        for (int hh = 0; hh < 2; ++hh) { const u32x4* p = (const u32x4*)((a == 0 ? Q : K) + (size_t)tok * 512 + (2 * part + hh) * 64);
            float s0 = 0.f, s1 = 0.f;
#pragma unroll
            for (int j = 0; j < 8; ++j) { const u32x4 w = p[j];
                s0 += bf_lo(w.x) * bf_lo(w.x) + bf_hi(w.x) * bf_hi(w.x) + bf_lo(w.y) * bf_lo(w.y) + bf_hi(w.y) * bf_hi(w.y);
                s1 += bf_lo(w.z) * bf_lo(w.z) + bf_hi(w.z) * bf_hi(w.z) + bf_lo(w.w) * bf_lo(w.w) + bf_hi(w.w) * bf_hi(w.w); }
            res[a * 2 + hh] = (s0 + s1) * 1.0001f + 1e-30f; }
#pragma unroll
    for (int i = 0; i < 4; ++i) { float v = res[i];
#pragma unroll
        for (int o = 4; o < 64; o <<= 1) v = fmaxf(v, __shfl_xor(v, o));
        res[i] = v; }
    if (c.lane < 4) {
#pragma unroll
        for (int a = 0; a < 2; ++a)
#pragma unroll
            for (int hh = 0; hh < 2; ++hh) atomicMax(nrm + (size_t)(b * 8 + 2 * part + hh) * 2 + a, __float_as_uint(res[a * 2 + hh]));
    }
}

__device__ __forceinline__ void pool_tile(const Ctx& c, int l, int tile) {
    const int tid = c.tid, lane = c.lane, wave = c.wave;
    const bf16_t* ZA = (const bf16_t*)(c.ws + WS_Z);
    bf16_t* Y = (bf16_t*)(c.ws + WS_XB);
    float* U = (float*)c.lds;
    float* Pm = (float*)(c.lds + 40960);
    const int t0 = tile * 128, pos0 = t0 & (SEQ - 1);
    u32x4 pre[3];
#define POOL_FETCH(gi_) do { _Pragma("unroll") for (int k_ = 0; k_ < 3; ++k_) { const int it_ = tid + 512 * k_; const int r_ = it_ >> 3, ch_ = it_ & 7; pre[k_] = (u32x4){0u, 0u, 0u, 0u}; \
        if (it_ < 143 * 8 && !(pos0 == 0 && r_ < 15)) pre[k_] = *(const u32x4*)(ZA + (size_t)(t0 - 15 + r_) * 512 + (gi_) * 64 + ch_ * 8); } } while (0)
    POOL_FETCH(0);
#pragma unroll 1
    for (int gi = 0; gi < 4; ++gi) {
        const int w = 2 << gi;
#pragma unroll
        for (int k = 0; k < 3; ++k) { const int it = tid + 512 * k; const int r = it >> 3, ch = it & 7;
            if (it < 143 * 8) { const u32x4 q = pre[k];
                *(f32x4*)(U + r * 64 + ch * 8) = (f32x4){bf_lo(q.x), bf_hi(q.x), bf_lo(q.y), bf_hi(q.y)}; *(f32x4*)(U + r * 64 + ch * 8 + 4) = (f32x4){bf_lo(q.z), bf_hi(q.z), bf_lo(q.w), bf_hi(q.w)}; } }
        __syncthreads();
        if (gi < 3) POOL_FETCH(gi + 1);
        {
            const int ch = tid & 63, i0 = (tid >> 6) * 16;
            float s = 0.f;
            for (int j = 1; j < w; ++j) s += U[(15 + i0 - j) * 64 + ch];
            for (int i = i0; i < i0 + 16; ++i) {
                const float cur = U[(15 + i) * 64 + ch]; s += cur;
                const int cnt = min(pos0 + i + 1, w);
                Pm[i * 65 + ch] = s / (float)cnt - cur;
                s -= U[(15 + i - (w - 1)) * 64 + ch];
            }
        }
        __syncthreads();
        {
            const int rt = wave >> 1, ct = wave & 1, li = lane & 31, lh = lane >> 5;
            const int j = 32 * ct + li;
            unsigned short gv[16];
#pragma unroll
            for (int r = 0; r < 16; ++r) { const int i = (r & 3) + 8 * (r >> 2) + 4 * lh; gv[r] = ZA[(size_t)(t0 + 32 * rt + i) * 512 + 256 + gi * 64 + j]; }
            const float* pw = c.inp(IN_POOLW) + (size_t)(l * 4 + gi) * 4096 + j;
            const float sc = c.inp(IN_POOLS)[l * 256 + gi * 64 + j];
            f32x16 acc = {};
#pragma unroll 8
            for (int s = 0; s < 32; ++s) {
                const float a = Pm[(32 * rt + li) * 65 + 2 * s + lh];
                const float b = pw[(size_t)(2 * s + lh) * 64];
                acc = __builtin_amdgcn_mfma_f32_32x32x2f32(a, b, acc, 0, 0, 0);
            }
#pragma unroll
            for (int r = 0; r < 16; ++r) {
                const int i = (r & 3) + 8 * (r >> 2) + 4 * lh; const size_t tok = (size_t)(t0 + 32 * rt + i);
                const float v = acc[r] * sc * silu_f(__uint_as_float((unsigned)gv[r] << 16));
                Y[tok * 1024 + gi * 64 + j] = (bf16_t)(pk_bf16(v, 0.f) & 0xffffu);
            }
        }
        __syncthreads();
    }
#undef POOL_FETCH
}

__device__ __forceinline__ void ssm_setup(const Ctx& c, int l, int g, int p, float& ar, float& ai, float (&bbr)[16], float (&bbi)[16]) {
    const int gp = (l * 16 + g) * 64 + p;
    const float are = c.inp(IN_ARE)[gp], aim = c.inp(IN_AIM)[gp], dt = expf(c.inp(IN_LOGDT)[l * 16 + g]);
    const float mag = expf(are * dt), ang = aim * dt;
    ar = mag * cosf(ang); ai = mag * sinf(ang);
    const float den = are * are + aim * aim, nr = ar - 1.0f;
    const float cr = (nr * are + ai * aim) / den, ci = (ai * are - nr * aim) / den;
    const f32x4* br = (const f32x4*)(c.inp(IN_BRE) + (size_t)gp * 16); const f32x4* bi = (const f32x4*)(c.inp(IN_BIM) + (size_t)gp * 16);
#pragma unroll
    for (int q = 0; q < 4; ++q) { const f32x4 r4 = br[q], i4 = bi[q];
#pragma unroll
        for (int i = 0; i < 4; ++i) { bbr[4 * q + i] = cr * r4[i] - ci * i4[i]; bbi[4 * q + i] = cr * i4[i] + ci * r4[i]; } }
}
typedef float f32x2s __attribute__((ext_vector_type(2)));
#define SSM_STEP(up) do { const f32x4 u0_ = (up)[0], u1_ = (up)[1], u2_ = (up)[2], u3_ = (up)[3]; \
    f32x2s s0_ = bb2[0] * u0_[0], s1_ = bb2[4] * u1_[0], s2_ = bb2[8] * u2_[0], s3_ = bb2[12] * u3_[0]; \
    _Pragma("unroll") for (int i_ = 1; i_ < 4; ++i_) { s0_ += bb2[i_] * u0_[i_]; s1_ += bb2[4 + i_] * u1_[i_]; s2_ += bb2[8 + i_] * u2_[i_]; s3_ += bb2[12 + i_] * u3_[i_]; } \
    const f32x2s bu_ = (s0_ + s1_) + (s2_ + s3_); \
    const f32x2s nx_ = (f32x2s){xr, xi} * ar + (f32x2s){-xi, xr} * ai + bu_; xr = nx_[0]; xi = nx_[1]; } while (0)

__device__ __forceinline__ void ssm_store_u(float* Ul, const u32x4 q, int lane) {
    if (lane < 32) { float* d = Ul + (lane >> 1) * 16 + (lane & 1) * 8;
        *(f32x4*)d = (f32x4){bf_lo(q.x), bf_hi(q.x), bf_lo(q.y), bf_hi(q.y)}; *(f32x4*)(d + 4) = (f32x4){bf_lo(q.z), bf_hi(q.z), bf_lo(q.w), bf_hi(q.w)}; }
}
__device__ __forceinline__ void ssm_pass1(const Ctx& c, int l) {
    const int gw = c.vcu * 8 + c.wave, NGW = c.G * 8, lane = c.lane;
    const bf16_t* ZC = (const bf16_t*)(c.ws + WS_Z + 5 * ZARR);
    float* send = (float*)(c.ws + WS_SEND);
    float* Ul = (float*)(c.lds + 81920 + c.wave * 1024);
    for (int task = gw; task < 2048; task += NGW) {
        const int bg = task >> 4, tk = task & 15, b = bg >> 4, g = bg & 15;
        if (tk == 15) continue;
        float ar, ai, bbr[16], bbi[16]; ssm_setup(c, l, g, lane, ar, ai, bbr, bbi);
        f32x2s bb2[16];
#pragma unroll
        for (int h_ = 0; h_ < 16; ++h_) bb2[h_] = (f32x2s){bbr[h_], bbi[h_]};
        float xr = 0.f, xi = 0.f;
        const size_t row0 = (size_t)b * SEQ + tk * 256;
        const bf16_t* up = ZC + (row0 + (lane >> 1)) * 512 + g * 16 + (lane & 1) * 8;
        u32x4 q[4];
#pragma unroll
        for (int i = 0; i < 4; ++i) { q[i] = (u32x4){0u, 0u, 0u, 0u}; if (lane < 32) q[i] = *(const u32x4*)(up + (size_t)i * 16 * 512); }
#pragma unroll 1
        for (int sub4 = 0; sub4 < 16; sub4 += 4) {
#pragma unroll
            for (int si = 0; si < 4; ++si) {
                ssm_store_u(Ul, q[si], lane);
                if (sub4 + 4 < 16 && lane < 32) q[si] = *(const u32x4*)(up + (size_t)(sub4 + si + 4) * 16 * 512);
                LDS_FENCE();
#pragma unroll 4
                for (int tt = 0; tt < 16; ++tt) SSM_STEP((const f32x4*)(Ul + tt * 16));
                LDS_FENCE();
            }
        }
        *(float2*)(send + ((size_t)(bg * 16 + tk) * 64 + lane) * 2) = make_float2(xr, xi);
    }
}
__device__ __forceinline__ void ssm_pass2(const Ctx& c, int l) {
    const int gw = c.vcu * 8 + c.wave, NGW = c.G * 8, lane = c.lane;
    const bf16_t* ZC = (const bf16_t*)(c.ws + WS_Z + 5 * ZARR);
    bf16_t* YG = (bf16_t*)(c.ws + WS_Z);
    const float* send = (const float*)(c.ws + WS_SEND);
    float* Ul = (float*)(c.lds + 81920 + c.wave * 1024);
    float* Xl = (float*)(c.lds + c.wave * 8448);
    for (int task = gw; task < 2048; task += NGW) {
        const int bg = task >> 4, tk = task & 15, b = bg >> 4, g = bg & 15;
        float ar, ai, bbr[16], bbi[16]; ssm_setup(c, l, g, lane, ar, ai, bbr, bbi);
        f32x2s bb2[16];
#pragma unroll
        for (int h_ = 0; h_ < 16; ++h_) bb2[h_] = (f32x2s){bbr[h_], bbi[h_]};
        float Cm[32];
        { const int h = lane & 15, kq = lane >> 4; const size_t cb = ((size_t)(l * 16 + g) * 16 + h) * 64;
#pragma unroll
          for (int s = 0; s < 16; ++s) { Cm[s] = c.inp(IN_CRE)[cb + 4 * s + kq]; Cm[16 + s] = -c.inp(IN_CIM)[cb + 4 * s + kq]; } }
        const float dsk = c.inp(IN_DSKIP)[l * 256 + g * 16 + (lane & 15)];
        float xr = 0.f, xi = 0.f;
        if (tk > 0) {
            float pr = ar, pi = ai;
#pragma unroll
            for (int q = 0; q < 8; ++q) { const float nr = pr * pr - pi * pi, ni = 2.f * pr * pi; pr = nr; pi = ni; }
            for (int j = 0; j < tk; ++j) { const float2 e = *(const float2*)(send + ((size_t)(bg * 16 + j) * 64 + lane) * 2);
                const float nr = pr * xr - pi * xi + e.x, ni = pr * xi + pi * xr + e.y; xr = nr; xi = ni; }
        }
        const size_t row0 = (size_t)b * SEQ + tk * 256;
        const bf16_t* up = ZC + (row0 + (lane >> 1)) * 512 + g * 16 + (lane & 1) * 8;
        u32x4 q[4];
#pragma unroll
        for (int i = 0; i < 4; ++i) { q[i] = (u32x4){0u, 0u, 0u, 0u}; if (lane < 32) q[i] = *(const u32x4*)(up + (size_t)i * 16 * 512); }
#pragma unroll 1
        for (int sub4 = 0; sub4 < 16; sub4 += 4)
#pragma unroll
        for (int si = 0; si < 4; ++si) {
            const int sub = sub4 + si;
            ssm_store_u(Ul, q[si], lane);
            if (sub4 + 4 < 16 && lane < 32) q[si] = *(const u32x4*)(up + (size_t)(sub + 4) * 16 * 512);
            LDS_FENCE();
            {
                f32x4 un[4];
#pragma unroll
                for (int k = 0; k < 4; ++k) un[k] = ((const f32x4*)Ul)[k];
#pragma unroll
                for (int tt = 0; tt < 16; ++tt) {
                    const f32x4 uc[4] = {un[0], un[1], un[2], un[3]};
                    if (tt + 1 < 16) {
#pragma unroll
                        for (int k = 0; k < 4; ++k) un[k] = ((const f32x4*)(Ul + (tt + 1) * 16))[k]; }
                    SSM_STEP(uc);
                    Xl[tt * 129 + lane] = xr; Xl[tt * 129 + 64 + lane] = xi;
                }
            }
            LDS_FENCE();
            f32x4 a0 = {0.f, 0.f, 0.f, 0.f}, a1 = {0.f, 0.f, 0.f, 0.f};
            const float* xa = Xl + (lane & 15) * 129 + (lane >> 4);
#pragma unroll
            for (int s = 0; s < 32; s += 2) {
                a0 = __builtin_amdgcn_mfma_f32_16x16x4f32(xa[4 * s], Cm[s], a0, 0, 0, 0);
                a1 = __builtin_amdgcn_mfma_f32_16x16x4f32(xa[4 * s + 4], Cm[s + 1], a1, 0, 0, 0);
            }
            const int h = lane & 15;
#pragma unroll
            for (int i = 0; i < 4; ++i) { const int tt = 4 * (lane >> 4) + i;
                float y = a0[i] + a1[i] + dsk * Ul[tt * 16 + h];
                const float z = 0.7978845608028654f * (y + 0.044715f * y * y * y);
                y = y * sigm(2.0f * z);
                YG[(row0 + sub * 16 + tt) * 256 + g * 16 + h] = (bf16_t)(pk_bf16(y, 0.f) & 0xffffu); }
            LDS_FENCE();
        }
    }
}

__device__ __forceinline__ void ssm2_coef(const Ctx& c, int l, int g, int p, int hi, float& ar, float& ai, float (&br)[8], float (&bi)[8]) {
    const int gp = (l * 16 + g) * 64 + p;
    const float are = c.inp(IN_ARE)[gp], aim = c.inp(IN_AIM)[gp], dt = expf(c.inp(IN_LOGDT)[l * 16 + g]);
    const float mag = expf(are * dt), ang = aim * dt;
    ar = mag * cosf(ang); ai = mag * sinf(ang);
    const float den = are * are + aim * aim, nr = ar - 1.0f;
    const float cr = (nr * are + ai * aim) / den, ci = (ai * are - nr * aim) / den;
    const f32x4* pr = (const f32x4*)(c.inp(IN_BRE) + (size_t)gp * 16 + 8 * hi); const f32x4* pi = (const f32x4*)(c.inp(IN_BIM) + (size_t)gp * 16 + 8 * hi);
#pragma unroll
    for (int q4 = 0; q4 < 2; ++q4) { const f32x4 r4 = pr[q4], i4 = pi[q4];
#pragma unroll
        for (int i = 0; i < 4; ++i) { br[4 * q4 + i] = cr * r4[i] - ci * i4[i]; bi[4 * q4 + i] = cr * i4[i] + ci * r4[i]; } }
}
__device__ __forceinline__ void split_bf16x8(const float (&v)[8], bf16x8& hi8, bf16x8& lo8) {
    u32x4 hw, lw;
#pragma unroll
    for (int k = 0; k < 4; ++k) { const unsigned h = pk_bf16(v[2 * k], v[2 * k + 1]); const unsigned lo = pk_bf16(v[2 * k] - bf_lo(h), v[2 * k + 1] - bf_hi(h)); hw[k] = h; lw[k] = lo; }
    hi8 = __builtin_bit_cast(bf16x8, hw); lo8 = __builtin_bit_cast(bf16x8, lw);
}
__device__ __forceinline__ float half_bcast(float x, int which) {
    auto rr = __builtin_amdgcn_permlane32_swap(__float_as_uint(x), __float_as_uint(x), false, false);
    return __uint_as_float(which == 0 ? rr[0] : rr[1]);
}
template <bool PASS2> __device__ __forceinline__ void ssm2_pass(const Ctx& c, int l) {
    const int gw = c.vcu * 8 + c.wave, NGW = c.G * 8, lane = c.lane, q = lane & 31, hi = lane >> 5;
    const bf16_t* ZC = (const bf16_t*)(c.ws + WS_Z + 5 * ZARR);
    bf16_t* YG = (bf16_t*)(c.ws + WS_Z);
    float* send = (float*)(c.ws + WS_SEND);
    float* Ul = (float*)(c.lds + 81920 + c.wave * 2048);
    unsigned* XP = (unsigned*)(c.lds + c.wave * 8448);
    for (int task = gw; task < 2048; task += NGW) {
        const int bg = task >> 4, tk = task & 15, b = bg >> 4, g = bg & 15;
        if (!PASS2 && tk == 15) continue;
        float arA, aiA, arB, aiB; bf16x8 Bh[4], Bl[4];
        { float t0[8], t1[8];
          ssm2_coef(c, l, g, q, hi, arA, aiA, t0, t1); split_bf16x8(t0, Bh[0], Bl[0]); split_bf16x8(t1, Bh[2], Bl[2]);
          ssm2_coef(c, l, g, 32 + q, hi, arB, aiB, t0, t1); split_bf16x8(t0, Bh[1], Bl[1]); split_bf16x8(t1, Bh[3], Bl[3]); }
        bf16x8 Cb[8]; float dsk = 0.f;
        if (PASS2) { const int h = lane & 15, kq = 4 * (lane >> 4); const size_t cb = ((size_t)(l * 16 + g) * 16 + h) * 64;
#pragma unroll
            for (int s_ = 0; s_ < 8; ++s_) { const float* src = (s_ < 4 ? c.inp(IN_CRE) : c.inp(IN_CIM)) + cb + 16 * (s_ & 3) + kq; const float sg = (s_ < 4) ? 1.f : -1.f;
                const f32x4 v0 = *(const f32x4*)src;
                const u32x4 w = {pk_bf16(sg * v0[0], sg * v0[0]), pk_bf16(sg * v0[1], sg * v0[1]), pk_bf16(sg * v0[2], sg * v0[2]), pk_bf16(sg * v0[3], sg * v0[3])};
                Cb[s_] = __builtin_bit_cast(bf16x8, w); }
            dsk = c.inp(IN_DSKIP)[l * 256 + g * 16 + h]; }
        float xAr = 0.f, xAi = 0.f, xBr = 0.f, xBi = 0.f;
        if (PASS2 && tk > 0) {
            float pAr = arA, pAi = aiA, pBr = arB, pBi = aiB;
#pragma unroll
            for (int k = 0; k < 8; ++k) { float nr = pAr * pAr - pAi * pAi, ni = 2.f * pAr * pAi; pAr = nr; pAi = ni; nr = pBr * pBr - pBi * pBi; ni = 2.f * pBr * pBi; pBr = nr; pBi = ni; }
            for (int j = 0; j < tk; ++j) { const float2 eA = *(const float2*)(send + ((size_t)(bg * 16 + j) * 64 + q) * 2), eB = *(const float2*)(send + ((size_t)(bg * 16 + j) * 64 + 32 + q) * 2);
                float nr = pAr * xAr - pAi * xAi + eA.x, ni = pAr * xAi + pAi * xAr + eA.y; xAr = nr; xAi = ni;
                nr = pBr * xBr - pBi * xBi + eB.x; ni = pBr * xBi + pBi * xBr + eB.y; xBr = nr; xBi = ni; }
        }
        const size_t row0 = (size_t)b * SEQ + tk * 256;
        const bf16_t* up = ZC + (row0 + q) * 512 + g * 16 + 8 * hi;
        bf16x8 an = *(const bf16x8*)up;
#pragma unroll 1
        for (int blk = 0; blk < 8; ++blk) {
            const bf16x8 a = an;
            if (blk + 1 < 8) an = *(const bf16x8*)(up + (size_t)(blk + 1) * 32 * 512);
            if (PASS2) { const u32x4 w = __builtin_bit_cast(u32x4, a); float* d = Ul + q * 16 + 8 * hi;
                *(f32x4*)d = (f32x4){bf_lo(w.x), bf_hi(w.x), bf_lo(w.y), bf_hi(w.y)}; *(f32x4*)(d + 4) = (f32x4){bf_lo(w.z), bf_hi(w.z), bf_lo(w.w), bf_hi(w.w)}; }
            f32x16 D0 = {}, D1 = {}, D2 = {}, D3 = {};
            D0 = __builtin_amdgcn_mfma_f32_32x32x16_bf16(a, Bh[0], D0, 0, 0, 0); D1 = __builtin_amdgcn_mfma_f32_32x32x16_bf16(a, Bh[1], D1, 0, 0, 0);
            D2 = __builtin_amdgcn_mfma_f32_32x32x16_bf16(a, Bh[2], D2, 0, 0, 0); D3 = __builtin_amdgcn_mfma_f32_32x32x16_bf16(a, Bh[3], D3, 0, 0, 0);
            D0 = __builtin_amdgcn_mfma_f32_32x32x16_bf16(a, Bl[0], D0, 0, 0, 0); D1 = __builtin_amdgcn_mfma_f32_32x32x16_bf16(a, Bl[1], D1, 0, 0, 0);
            D2 = __builtin_amdgcn_mfma_f32_32x32x16_bf16(a, Bl[2], D2, 0, 0, 0); D3 = __builtin_amdgcn_mfma_f32_32x32x16_bf16(a, Bl[3], D3, 0, 0, 0);
#pragma unroll
            for (int gq = 0; gq < 4; ++gq) {
#pragma unroll
                for (int ps = 0; ps < 2; ++ps) {
#pragma unroll
                    for (int i = 0; i < 4; ++i) { const int r = 4 * gq + i;
                        float nr = arA * xAr - aiA * xAi + D0[r], ni = arA * xAi + aiA * xAr + D2[r]; xAr = nr; xAi = ni;
                        nr = arB * xBr - aiB * xBi + D1[r]; ni = arB * xBi + aiB * xBr + D3[r]; xBr = nr; xBi = ni;
                        if (PASS2) { if (hi == ps) { const int row = (8 * gq + 4 * ps + i) & 15;
                            const unsigned hr = pk_bf16(xAr, xBr), hm = pk_bf16(xAi, xBi);
                            const unsigned lr = pk_bf16(xAr - bf_lo(hr), xBr - bf_hi(hr)), lm = pk_bf16(xAi - bf_lo(hm), xBi - bf_hi(hm));
                            XP[row * 132 + q] = (hr & 0xffffu) | (lr << 16); XP[row * 132 + 32 + q] = (hr >> 16) | (lr & 0xffff0000u);
                            XP[row * 132 + 64 + q] = (hm & 0xffffu) | (lm << 16); XP[row * 132 + 96 + q] = (hm >> 16) | (lm & 0xffff0000u); } } }
                    xAr = half_bcast(xAr, ps); xAi = half_bcast(xAi, ps); xBr = half_bcast(xBr, ps); xBi = half_bcast(xBi, ps);
                }
                if (PASS2 && (gq & 1)) {
                    LDS_FENCE();
                    f32x4 a0 = {0.f, 0.f, 0.f, 0.f}, a1 = {0.f, 0.f, 0.f, 0.f};
                    const unsigned* xp = XP + (lane & 15) * 132 + 4 * (lane >> 4);
#pragma unroll
                    for (int s_ = 0; s_ < 8; s_ += 2) {
                        a0 = __builtin_amdgcn_mfma_f32_16x16x32_bf16(*(const bf16x8*)(xp + 16 * s_), Cb[s_], a0, 0, 0, 0);
                        a1 = __builtin_amdgcn_mfma_f32_16x16x32_bf16(*(const bf16x8*)(xp + 16 * s_ + 16), Cb[s_ + 1], a1, 0, 0, 0);
                    }
                    const int h = lane & 15, t16 = (gq >> 1) * 16;
#pragma unroll
                    for (int i = 0; i < 4; ++i) { const int tt = 4 * (lane >> 4) + i;
                        float y = a0[i] + a1[i] + dsk * Ul[(t16 + tt) * 16 + h];
                        const float z = 0.7978845608028654f * (y + 0.044715f * y * y * y);
                        y = y * sigm(2.0f * z);
                        YG[(row0 + blk * 32 + t16 + tt) * 256 + g * 16 + h] = (bf16_t)(pk_bf16(y, 0.f) & 0xffffu); }
                    LDS_FENCE();
                }
            }
        }
        if (!PASS2) { if (hi == 0) { *(float2*)(send + ((size_t)(bg * 16 + tk) * 64 + q) * 2) = make_float2(xAr, xAi); *(float2*)(send + ((size_t)(bg * 16 + tk) * 64 + 32 + q) * 2) = make_float2(xBr, xBi); } }
    }
}

namespace fox {
constexpr int D = 64, PITCH = 512, NW = 8, QBLK = 32, QB = 256, KVBLK = 64;
constexpr int SLOTB = 8192;
constexpr int NSLOT = 4;
constexpr int L_K = 0, L_V = NSLOT * SLOTB, L_WS = 2 * NSLOT * SLOTB, L_OST = L_WS + NW * 64 * 4, L_F = L_OST + NW * 4096, L_END = L_F + SEQ * 4;
__device__ __forceinline__ int crow(int r, int hi) { return (r & 3) + 8 * (r >> 2) + 4 * hi; }
__device__ __forceinline__ void glds16(const void* gsrc, unsigned lds_dst) { unsigned keep;
    asm volatile("s_mov_b32 %0, m0\n\ts_mov_b32 m0, %2\n\ts_nop 0\n\tglobal_load_lds_dwordx4 %1, off\n\ts_mov_b32 m0, %0" : "=&s"(keep) : "v"(gsrc), "s"(lds_dst) : "memory"); }
typedef __attribute__((address_space(3))) const char* lds_cptr;
typedef short v4i16_t __attribute__((ext_vector_type(4)));
__device__ __forceinline__ s16x4 vtr(lds_cptr p) { return __builtin_bit_cast(s16x4, __builtin_amdgcn_ds_read_tr16_b64_v4i16((__attribute__((address_space(3))) v4i16_t*)p)); }
#define FOX_WAIT_BAR(N) asm volatile("s_waitcnt vmcnt(" #N ") lgkmcnt(0)\n\ts_barrier" ::: "memory")

__device__ __forceinline__ void attn_unit(const Ctx& c, int b, int h, int qb) {
    const int tid = c.tid, lane = c.lane, r32 = lane & 31, hi = lane >> 5, wid = c.wave;
    const bf16_t* Q = (const bf16_t*)(c.ws + WS_Z + 1 * ZARR); const bf16_t* K = (const bf16_t*)(c.ws + WS_Z + 2 * ZARR); const bf16_t* V = (const bf16_t*)(c.ws + WS_Z + 3 * ZARR);
    const bf16_t* GB = (const bf16_t*)(c.ws + WS_Z + 4 * ZARR); bf16_t* Y = (bf16_t*)(c.ws + WS_XB);
    const float* Fbh = (const float*)(c.ws + WS_FCUM) + (size_t)(b * NHEAD + h) * SEQ;
    char* shm = (char*)c.lds;
    const long rowbase = (long)b * SEQ; const int q0 = qb * QB;
    const bf16_t* Qw = Q + (rowbase + q0 + wid * QBLK) * PITCH + h * D;
    const bf16_t* Kh = K + rowbase * PITCH + h * D; const bf16_t* Vh = V + rowbase * PITCH + h * D;
    const unsigned lds0 = (unsigned)(uintptr_t)shm;
    float* wsf = (float*)(shm + L_WS) + wid * 64;
    float* Fl = (float*)(shm + L_F);
    const bf16_t* ksrc = Kh + (long)lane * PITCH + wid * 8;
    const bf16_t* vsrc = Vh + (long)(16 * (wid & 3) + (lane >> 2)) * PITCH + (wid >> 2) * 32 + (lane & 3) * 8;
    const unsigned kdst = lds0 + L_K + wid * 1024, vdst = lds0 + L_V + wid * 1024;
#define DMA_K(t, slot) glds16(ksrc + (long)(t) * KVBLK * PITCH, (unsigned)__builtin_amdgcn_readfirstlane(kdst + (slot)))
#define DMA_V(t, slot) glds16(vsrc + (long)(t) * KVBLK * PITCH, (unsigned)__builtin_amdgcn_readfirstlane(vdst + (slot)))
    const lds_cptr shm3 = (lds_cptr)(__attribute__((address_space(3))) const char*)(__attribute__((address_space(3))) unsigned char*)(uintptr_t)lds0;
    const lds_cptr vp0 = shm3 + L_V + ((lane >> 4) & 1) * 32 + (lane & 3) * 8 + (4 * hi + ((lane & 15) >> 2)) * 64;
    const int NT = (q0 + QB) / KVBLK;
    for (int i = tid; i < (q0 + QB) / 4; i += 512) *(f32x4*)(Fl + 4 * i) = *(const f32x4*)(Fbh + 4 * i);
    const float fq = Fbh[q0 + wid * QBLK + r32];
    bf16x8 qr[4];
#pragma unroll
    for (int d0 = 0; d0 < 4; ++d0) qr[d0] = *reinterpret_cast<const bf16x8*>(&Qw[(long)r32 * PITCH + d0 * 16 + hi * 8]);
    DMA_K(0, 0); DMA_V(0, 0); DMA_K(1, SLOTB); DMA_V(1, SLOTB); DMA_K(2, 2 * SLOTB); DMA_V(2, 2 * SLOTB);
    float mhat = -1e30f, l_reg = 0.f; f32x16 o[2]; o[0] = f32x16{}; o[1] = f32x16{};
    const int qrel = wid * QBLK + r32;
    for (int t = 0; t < NT; ++t) {
        const int cur = (t & 3) * SLOTB;
        if (t + 2 < NT) { FOX_WAIT_BAR(4); } else if (t + 1 < NT) { FOX_WAIT_BAR(2); } else { FOX_WAIT_BAR(0); }
        if (t + 3 < NT) { const int nxs = ((t + 3) & 3) * SLOTB; DMA_K(t + 3, nxs); DMA_V(t + 3, nxs); }
        const int jb = t - (NT - 4);
        if (!(jb > 0 && 64 * jb > wid * QBLK + 31)) {
            f32x16 p0, p1;
            { const float* fk = Fl + t * 64 + 4 * hi;
#pragma unroll
              for (int g = 0; g < 4; ++g) { const f32x4 a = *(const f32x4*)(fk + 8 * g), bb = *(const f32x4*)(fk + 32 + 8 * g);
#pragma unroll
                for (int i = 0; i < 4; ++i) { p0[4 * g + i] = fq - a[i]; p1[4 * g + i] = fq - bb[i]; } } }
            { const char* kb = shm + L_K + cur + hi * 1024 + r32 * 16;
#pragma unroll
              for (int d0 = 0; d0 < 4; ++d0) {
                const bf16x8 b0 = *reinterpret_cast<const bf16x8*>(kb + d0 * 2048);
                const bf16x8 b1 = *reinterpret_cast<const bf16x8*>(kb + d0 * 2048 + 512);
                p0 = __builtin_amdgcn_mfma_f32_32x32x16_bf16(b0, qr[d0], p0, 0, 0, 0);
                p1 = __builtin_amdgcn_mfma_f32_32x32x16_bf16(b1, qr[d0], p1, 0, 0, 0); } }
            if (jb >= 0) { const int kbase = 64 * jb + 4 * hi;
#pragma unroll
                for (int r = 0; r < 16; ++r) { const int kv = kbase + (r & 3) + 8 * (r >> 2); if (kv > qrel) p0[r] = -INFINITY; if (kv + 32 > qrel) p1[r] = -INFINITY; } }
            float rm;
            { float m0 = fmaxf(p0[0], p0[1]), m1 = fmaxf(p0[2], p0[3]), m2 = fmaxf(p1[0], p1[1]), m3 = fmaxf(p1[2], p1[3]);
#pragma unroll
              for (int r = 4; r < 16; r += 4) { m0 = fmaxf(fmaxf(m0, p0[r]), p0[r + 1]); m1 = fmaxf(fmaxf(m1, p0[r + 2]), p0[r + 3]); m2 = fmaxf(fmaxf(m2, p1[r]), p1[r + 1]); m3 = fmaxf(fmaxf(m3, p1[r + 2]), p1[r + 3]); }
              rm = fmaxf(fmaxf(m0, m1), fmaxf(m2, m3)); }
            { auto rr = __builtin_amdgcn_permlane32_swap(__float_as_uint(rm), __float_as_uint(rm), false, false); rm = fmaxf(__uint_as_float(rr[0]), __uint_as_float(rr[1])); }
            const float mnew = fmaxf(mhat, rm);
            const float f = __builtin_amdgcn_exp2f(mhat - mnew);
            mhat = mnew;
            float sacc;
            { float s0 = 0.f, s1 = 0.f, s2 = 0.f, s3 = 0.f;
#pragma unroll
              for (int r = 0; r < 16; r += 2) { p0[r] = __builtin_amdgcn_exp2f(p0[r] - mhat); p1[r] = __builtin_amdgcn_exp2f(p1[r] - mhat); p0[r + 1] = __builtin_amdgcn_exp2f(p0[r + 1] - mhat); p1[r + 1] = __builtin_amdgcn_exp2f(p1[r + 1] - mhat);
                  s0 += p0[r]; s1 += p1[r]; s2 += p0[r + 1]; s3 += p1[r + 1]; }
              sacc = (s0 + s1) + (s2 + s3); }
            l_reg = l_reg * f + sacc;
            if (__any(f != 1.0f)) {
                if (hi == 0) wsf[r32] = f;
                LDS_FENCE();
#pragma unroll
                for (int g = 0; g < 4; ++g) { const f32x4 fv = *(const f32x4*)(wsf + 8 * g + 4 * hi);
#pragma unroll
                    for (int i = 0; i < 4; ++i) { o[0][4 * g + i] *= fv[i]; o[1][4 * g + i] *= fv[i]; } }
                LDS_FENCE();
            }
            u32x4 pw0, pw1, pw2, pw3;
            pw0 = (u32x4){pk_bf16(p0[0], p0[1]), pk_bf16(p0[2], p0[3]), pk_bf16(p0[4], p0[5]), pk_bf16(p0[6], p0[7])};
            pw1 = (u32x4){pk_bf16(p0[8], p0[9]), pk_bf16(p0[10], p0[11]), pk_bf16(p0[12], p0[13]), pk_bf16(p0[14], p0[15])};
            pw2 = (u32x4){pk_bf16(p1[0], p1[1]), pk_bf16(p1[2], p1[3]), pk_bf16(p1[4], p1[5]), pk_bf16(p1[6], p1[7])};
            pw3 = (u32x4){pk_bf16(p1[8], p1[9]), pk_bf16(p1[10], p1[11]), pk_bf16(p1[12], p1[13]), pk_bf16(p1[14], p1[15])};
            const bf16x8 pa[4] = {__builtin_bit_cast(bf16x8, pw0), __builtin_bit_cast(bf16x8, pw1), __builtin_bit_cast(bf16x8, pw2), __builtin_bit_cast(bf16x8, pw3)};
            const lds_cptr vp = vp0 + cur;
#pragma unroll
            for (int ks = 0; ks < 4; ++ks)
#pragma unroll
                for (int d0 = 0; d0 < 2; ++d0) {
                    const s16x4 lo = vtr(vp + d0 * 4096 + ks * 1024), hh = vtr(vp + d0 * 4096 + ks * 1024 + 512);
                    const bf16x8 vf = (bf16x8){lo[0], lo[1], lo[2], lo[3], hh[0], hh[1], hh[2], hh[3]};
                    o[d0] = __builtin_amdgcn_mfma_f32_32x32x16_bf16(pa[ks], vf, o[d0], 0, 0, 0);
                }
        }
    }
    { auto rr = __builtin_amdgcn_permlane32_swap(__float_as_uint(l_reg), __float_as_uint(l_reg), false, false); l_reg = __uint_as_float(rr[0]) + __uint_as_float(rr[1]); }
    if (hi == 0) wsf[32 + r32] = l_reg;
    LDS_FENCE();
    float rli[16];
#pragma unroll
    for (int r = 0; r < 16; ++r) rli[r] = __builtin_amdgcn_rcpf(wsf[32 + crow(r, hi)]);
    {
        bf16_t* stg = (bf16_t*)(shm + L_OST) + wid * 2048;
#pragma unroll
        for (int r = 0; r < 16; ++r) { const int orow = crow(r, hi);
#pragma unroll
            for (int d0 = 0; d0 < 2; ++d0) stg[orow * 64 + d0 * 32 + r32] = (bf16_t)(pk_bf16(o[d0][r] * rli[r], 0.f) & 0xffffu); }
        LDS_FENCE();
        const long grow0 = rowbase + q0 + wid * QBLK;
#pragma unroll
        for (int i = 0; i < 4; ++i) { const int row = i * 8 + (lane >> 3), ch = lane & 7;
            const u32x4 v = *(const u32x4*)(stg + row * 64 + ch * 8);
            const u32x4 g = *(const u32x4*)(GB + (grow0 + row) * PITCH + h * D + ch * 8);
            u32x4 w;
            w.x = pk_bf16(bf_lo(v.x) * bf_lo(g.x), bf_hi(v.x) * bf_hi(g.x)); w.y = pk_bf16(bf_lo(v.y) * bf_lo(g.y), bf_hi(v.y) * bf_hi(g.y));
            w.z = pk_bf16(bf_lo(v.z) * bf_lo(g.z), bf_hi(v.z) * bf_hi(g.z)); w.w = pk_bf16(bf_lo(v.w) * bf_lo(g.w), bf_hi(v.w) * bf_hi(g.w));
            *(u32x4*)(Y + (grow0 + row) * 1024 + 256 + h * D + ch * 8) = w; }
    }
    asm volatile("s_waitcnt lgkmcnt(0)\n\ts_barrier" ::: "memory");
#undef DMA_K
#undef DMA_V
}
__device__ __forceinline__ void attn_phase(const Ctx& c) {
    for (int v = c.vcu; v < 256; v += c.G) {
        const int bh = v >> 2, j = v & 3;
#pragma unroll 1
        for (int i = 0; i < 4; ++i) { const int qb = (i == 0) ? j : (i == 1) ? 7 - j : (i == 2) ? 8 + j : 15 - j; attn_unit(c, bh >> 3, bh & 7, qb); }
    }
}
}


namespace fox2 {
using bf16=__hip_bfloat16;
using bf16x8=__attribute__((ext_vector_type(8)))short;
using s16x4=__attribute__((ext_vector_type(4)))short;
using f32x16=__attribute__((ext_vector_type(16)))float;
using u32x4=__attribute__((ext_vector_type(4)))unsigned;
typedef float f32x4v __attribute__((ext_vector_type(4)));
constexpr int D=64,PITCH=512;
constexpr int NW=8,QBLK=32,QB=QBLK*NW,KVBLK=64;
#define SBAR() __builtin_amdgcn_sched_barrier(0)
__device__ __forceinline__ int crow(int r,int hi){return (r&3)+8*(r>>2)+4*hi;}
#define SBAR() __builtin_amdgcn_sched_barrier(0)
__device__ __forceinline__ void cmask(f32x16&p0,f32x16&p1,int jb,int qrel,int hi){
  const float NEG=-INFINITY; int kb=64*jb+4*hi;
  #pragma unroll
  for(int r=0;r<16;++r){int kv=kb+(r&3)+8*(r>>2); if(kv>qrel)p0[r]=NEG; if(kv+32>qrel)p1[r]=NEG;}
}

constexpr int NSLOT=3, SLOTB=8192;
constexpr int LDS_K=0, LDS_V=NSLOT*SLOTB, LDS_WS=2*NSLOT*SLOTB, LDS_OST=LDS_WS+NW*64*4, LDS_F=LDS_OST+NW*4096, LDS_G=LDS_F+SEQ*4, LDS_BYTES=LDS_G+NW*4096;
constexpr float C2=0.125f*1.4426950408889634f;
__device__ __forceinline__ void glds16(const void*gsrc,unsigned lds_dst){unsigned keep;
  asm volatile("s_mov_b32 %0, m0\n\ts_mov_b32 m0, %2\n\ts_nop 0\n\tglobal_load_lds_dwordx4 %1, off\n\ts_mov_b32 m0, %0":"=&s"(keep):"v"(gsrc),"s"(lds_dst):"memory");}
__device__ __forceinline__ float max3f(float a,float b,float c){float r;asm("v_max3_f32 %0, %1, %2, %3":"=v"(r):"v"(a),"v"(b),"v"(c));return r;}
__device__ __forceinline__ float max2f(float a,float b){float r;asm("v_max_f32_e32 %0, %1, %2":"=v"(r):"v"(a),"v"(b));return r;}
__device__ __forceinline__ float fadd_s(float a,float b){float r;asm("v_add_f32_e32 %0, %1, %2":"=v"(r):"v"(a),"v"(b));return r;}
__device__ __forceinline__ float fsub_s(float a,float b){float r;asm("v_sub_f32_e32 %0, %1, %2":"=v"(r):"v"(a),"v"(b));return r;}
typedef float f32x2_t __attribute__((ext_vector_type(2))); typedef __bf16 bf16x2_t __attribute__((ext_vector_type(2)));
__device__ __forceinline__ unsigned cvtpk_s(float lo,float hi){f32x2_t v={lo,hi};bf16x2_t b=__builtin_convertvector(v,bf16x2_t);return __builtin_bit_cast(unsigned,b);}
#define WAIT_BAR(N) asm volatile("s_waitcnt vmcnt(" #N ") lgkmcnt(0)\n\ts_barrier":::"memory")

__device__ __forceinline__ void qkt(f32x16&p0,f32x16&p1,const char*Kslot,const bf16x8*qr,int r32,int hi){
  const char*kb=Kslot+hi*1024+r32*16;
  #pragma unroll
  for(int d0=0;d0<4;++d0){
    const bf16x8 b0=*reinterpret_cast<const bf16x8*>(kb+d0*2048);
    const bf16x8 b1=*reinterpret_cast<const bf16x8*>(kb+d0*2048+512);
    p0=__builtin_amdgcn_mfma_f32_32x32x16_bf16(b0,qr[d0],p0,0,0,0);p1=__builtin_amdgcn_mfma_f32_32x32x16_bf16(b1,qr[d0],p1,0,0,0);}
}
typedef __attribute__((address_space(3))) const char* lds_cptr;
typedef short v4i16_t __attribute__((ext_vector_type(4)));
__device__ __forceinline__ void kload8(bf16x8*kf,lds_cptr kp){
  kf[0]=*(const __attribute__((address_space(3))) bf16x8*)(kp);      kf[1]=*(const __attribute__((address_space(3))) bf16x8*)(kp+512);
  kf[2]=*(const __attribute__((address_space(3))) bf16x8*)(kp+2048); kf[3]=*(const __attribute__((address_space(3))) bf16x8*)(kp+2560);
  kf[4]=*(const __attribute__((address_space(3))) bf16x8*)(kp+4096); kf[5]=*(const __attribute__((address_space(3))) bf16x8*)(kp+4608);
  kf[6]=*(const __attribute__((address_space(3))) bf16x8*)(kp+6144); kf[7]=*(const __attribute__((address_space(3))) bf16x8*)(kp+6656);
}
__device__ __forceinline__ void kload2(bf16x8*kf,lds_cptr kp,int j){ kf[2*j]=*(const __attribute__((address_space(3))) bf16x8*)(kp+j*2048); kf[2*j+1]=*(const __attribute__((address_space(3))) bf16x8*)(kp+j*2048+512); }
__device__ __forceinline__ s16x4 vtr(lds_cptr p){ return __builtin_bit_cast(s16x4,__builtin_amdgcn_ds_read_tr16_b64_v4i16((__attribute__((address_space(3))) v4i16_t*)p)); }
__device__ __forceinline__ float rowmax(const f32x16&p0,const f32x16&p1){
  float a=max3f(p0[0],p0[1],p1[0]),b=max3f(p0[2],p0[3],p1[1]);a=max3f(a,p1[2],p1[3]);
  #pragma unroll
  for(int r=4;r<16;r+=4){a=max3f(a,p0[r],p0[r+1]);b=max3f(b,p0[r+2],p0[r+3]);a=max3f(a,p1[r],p1[r+1]);b=max3f(b,p1[r+2],p1[r+3]);}
  const float m=max2f(a,b);
  auto rr=__builtin_amdgcn_permlane32_swap(__float_as_uint(m),__float_as_uint(m),false,false);
  return max2f(__uint_as_float(rr[0]),__uint_as_float(rr[1]));
}
__device__ __forceinline__ void pv(f32x16*o,int vb,bf16x8 pa0,bf16x8 pa1,bf16x8 pa2,bf16x8 pa3){
  #pragma unroll
  for(int d0=0;d0<2;++d0){s16x4 lo[4],hi[4];
    #pragma unroll
    for(int ks=0;ks<4;++ks){
      asm volatile("ds_read_b64_tr_b16 %0,%1 offset:%c2":"=&v"(lo[ks]):"v"(vb),"i"(d0*4096+ks*1024):"memory");
      asm volatile("ds_read_b64_tr_b16 %0,%1 offset:%c2":"=&v"(hi[ks]):"v"(vb),"i"(d0*4096+ks*1024+512):"memory");}
    asm volatile("s_waitcnt lgkmcnt(0)":::"memory");SBAR();
    #define PK(k) (bf16x8){lo[k][0],lo[k][1],lo[k][2],lo[k][3],hi[k][0],hi[k][1],hi[k][2],hi[k][3]}
    o[d0]=__builtin_amdgcn_mfma_f32_32x32x16_bf16(pa0,PK(0),o[d0],0,0,0);
    o[d0]=__builtin_amdgcn_mfma_f32_32x32x16_bf16(pa1,PK(1),o[d0],0,0,0);
    o[d0]=__builtin_amdgcn_mfma_f32_32x32x16_bf16(pa2,PK(2),o[d0],0,0,0);
    o[d0]=__builtin_amdgcn_mfma_f32_32x32x16_bf16(pa3,PK(3),o[d0],0,0,0);
    #undef PK
  }
}

#ifndef ATTN_STORE16
#define ATTN_STORE16(p,v) (*(u32x4*)(p)=(v))
#endif
template<int THRL> __device__ __forceinline__ void attn_unit(int b,int h,int qb,const bf16*Q,const bf16*__restrict__ K,const bf16*__restrict__ V,const unsigned short*GB,unsigned short*Y,const float*Fcum,int ts,char*shm){
  int tid_=threadIdx.x; asm volatile("":"+v"(tid_));
  const int tid=tid_,lane=tid&63,r32=lane&31,hi=lane>>5; const int wid=__builtin_amdgcn_readfirstlane(tid>>6);
  const long rowbase=(long)b*SEQ; const int q0=qb*QB;
  const bf16*Qw=Q+(rowbase+q0+wid*QBLK)*PITCH+h*D;
  const float*Fbh=Fcum+(long)(b*NHEAD+h)*SEQ; float*Fl=(float*)(shm+LDS_F);
  const bf16*Kh=K+(rowbase+(long)ts*KVBLK)*PITCH+h*D,*Vh=V+(rowbase+(long)ts*KVBLK)*PITCH+h*D;
  const unsigned lds0=(unsigned)(uintptr_t)shm;
  float*wsf=(float*)(shm+LDS_WS)+wid*64;
  const bf16*ksrc=Kh+(long)lane*PITCH+wid*8;
  const bf16*vsrc=Vh+(long)(16*(wid&3)+(lane>>2))*PITCH+(wid>>2)*32+(lane&3)*8;
  const unsigned kdst=lds0+LDS_K+wid*1024, vdst=lds0+LDS_V+wid*1024;
  #define DMA_K(t,slot) glds16(ksrc+(long)(t)*KVBLK*PITCH,(unsigned)__builtin_amdgcn_readfirstlane(kdst+(slot)))
  #define DMA_V(t,slot) glds16(vsrc+(long)(t)*KVBLK*PITCH,(unsigned)__builtin_amdgcn_readfirstlane(vdst+(slot)))
  const int vb0=(int)(lds0+LDS_V)+((lane>>4)&1)*32+(lane&3)*8+(4*hi+((lane&15)>>2))*64;
  const char*Kbase=shm+LDS_K; bf16x8 kf[8];
  const lds_cptr shm3=(lds_cptr)shm; const lds_cptr kp0=shm3+LDS_K+hi*1024+r32*16; const lds_cptr vp0=shm3+LDS_V+((lane>>4)&1)*32+(lane&3)*8+(4*hi+((lane&15)>>2))*64;
  const int NT=(q0+QB)/KVBLK-ts;
  { const int np=(NT+3)>>2;
    if(wid<np)glds16((const char*)(Fbh+64*ts)+wid*1024+lane*16,(unsigned)__builtin_amdgcn_readfirstlane(lds0+LDS_F+wid*1024));
    if(wid+8<np)glds16((const char*)(Fbh+64*ts)+(wid+8)*1024+lane*16,(unsigned)__builtin_amdgcn_readfirstlane(lds0+LDS_F+(wid+8)*1024));
    const unsigned short*gsrc=GB+(rowbase+q0+wid*QBLK+(lane>>3))*PITCH+h*D+(lane&7)*8;
    #pragma unroll
    for(int i=0;i<4;++i)glds16(gsrc+(long)i*8*PITCH,(unsigned)__builtin_amdgcn_readfirstlane(lds0+LDS_G+wid*4096+i*1024)); }
  float nb=Fbh[q0+wid*QBLK+r32];
  DMA_K(0,0);DMA_V(0,0);DMA_K(1,SLOTB);
  bf16x8 qr[4];
  #pragma unroll
  for(int d0=0;d0<4;++d0)qr[d0]=*reinterpret_cast<const bf16x8*>(&Qw[(long)r32*PITCH+d0*16+hi*8]);
  float mhat=0.f,l_reg=0.f;f32x16 o[2];o[0]=f32x16{};o[1]=f32x16{};
  #define CINIT(X0,X1,tt) do{ const float*fk_=Fl+(tt)*64+4*hi; _Pragma("unroll") for(int g_=0;g_<4;++g_){ const f32x4v a_=*(const f32x4v*)(fk_+8*g_), b_=*(const f32x4v*)(fk_+32+8*g_); \
      _Pragma("unroll") for(int i_=0;i_<4;++i_){ X0[4*g_+i_]=nb-a_[i_]; X1[4*g_+i_]=nb-b_[i_]; } } }while(0)
  #define CINIT4(X,tt,off,g_) do{ const f32x4v a_=*(const f32x4v*)(Fl+(tt)*64+4*hi+(off)+8*(g_)); X[4*(g_)]=nb-a_[0]; X[4*(g_)+1]=nb-a_[1]; X[4*(g_)+2]=nb-a_[2]; X[4*(g_)+3]=nb-a_[3]; PIN(X); }while(0)
  const int qrel=wid*QBLK+r32;
  #define CMASK(P0,P1,t) do{int jb_=(t)-(NT-4); if(jb_>=0)cmask(P0,P1,jb_,qrel,hi);}while(0)
  bool resc=false;
  #define START(P0,P1) do{ const float rm=rowmax(P0,P1); resc=false; \
    { const float dl=max2f(rm,0.f);     \
      mhat=fadd_s(mhat,dl); \
      _Pragma("unroll") for(int r=0;r<16;++r){P0[r]=fsub_s(P0[r],dl);P1[r]=fsub_s(P1[r],dl);} \
      nb=fsub_s(nb,dl); } \
    _Pragma("unroll") for(int r=0;r<16;++r)P0[r]=__builtin_amdgcn_exp2f(P0[r]); }while(0)
  #define RESC() do{ if(resc){ asm volatile("s_waitcnt lgkmcnt(0)":::"memory"); \
      _Pragma("unroll") for(int d_=0;d_<2;++d_) _Pragma("unroll") for(int r=0;r<16;++r)o[d_][r]*=wsf[crow(r,hi)]; } }while(0)
  f32x16 pA0,pA1,pB0,pB1;
  int sl_prev=0,sl_cur=0,sl_next=SLOTB;
  #define ROT() do{sl_prev=sl_cur;sl_cur=sl_next;sl_next=(sl_next==(NSLOT-1)*SLOTB)?0:sl_next+SLOTB;}while(0)
  DMA_K(2,2*SLOTB);
  WAIT_BAR(3);
  CINIT(pA0,pA1,0);
  qkt(pA0,pA1,Kbase,qr,r32,hi);asm volatile("s_nop 15\n\ts_nop 7":"+v"(pA0),"+v"(pA1));CMASK(pA0,pA1,0);
  START(pA0,pA1);
  _Pragma("unroll") for(int r=0;r<16;++r)pA1[r]=__builtin_amdgcn_exp2f(pA1[r]);
  CINIT(pB0,pB1,1);
  WAIT_BAR(0);
  DMA_K(3,0);DMA_V(1,SLOTB);
  ROT();
  kload8(kf,kp0+sl_cur);
  WAIT_BAR(2);
  s16x4 vlo[8],vhi[8]; u32x4 pw0,pw1,pw2,pw3;
  #define PKW(P,B) cvtpk_s(P[B],P[B+1])
  #define PAF(k) __builtin_bit_cast(bf16x8,pw##k)
  #define VFR(i) (bf16x8){vlo[i][0],vlo[i][1],vlo[i][2],vlo[i][3],vhi[i][0],vhi[i][1],vhi[i][2],vhi[i][3]}
  #define PIN(x) asm volatile("":"+v"(x))
  #define MX3(a,b,c) __builtin_fmaxf(__builtin_fmaxf((a),(b)),(c))
  #define GAPA(MF,A0,A1,A2,A3,W0,W1,PW) do{ MF; sacc+=A0; sacc+=A1; sacc+=A2; sacc+=A3; PIN(sacc); W0; W1; PIN(PW); SBAR(); }while(0)
  #define EX(v) __builtin_amdgcn_exp2f(v)
  #define GAPB(MF,X,B,NI) do{ MF; X[B]=EX(X[B]); X[B+1]=EX(X[B+1]); X[B+2]=EX(X[B+2]); X[B+3]=EX(X[B+3]); PIN(X); NI; SBAR(); }while(0)
  #define NIN(G,X,tt,off,g_) do{ if(G){ CINIT4(X,tt,off,g_); } }while(0)
  #define VRD(i) do{ vlo[i]=vtr(vp_+(((i)>>2)*4096+((i)&3)*1024)); vhi[i]=vtr(vp_+(((i)>>2)*4096+((i)&3)*1024+512)); }while(0)
  #define KRD(G,j) do{ if(G){ kload2(kf,kp0+sl_next,j); SBAR(); } }while(0)
  #define STEP(C0,C1,P0,P1,t,GK,GV,GL) do{ SBAR(); \
    const lds_cptr vp_=vp0+sl_prev; \
    VRD(0); SBAR(); float sacc=(P0[0]+P0[1]); \
    GAPA(C0=__builtin_amdgcn_mfma_f32_32x32x16_bf16(kf[0],qr[0],C0,0,0,0), P0[2],P0[3],P0[4],P0[5],     pw0[0]=PKW(P0,0), pw0[1]=PKW(P0,2), pw0); \
    VRD(4); SBAR(); GAPA(C1=__builtin_amdgcn_mfma_f32_32x32x16_bf16(kf[1],qr[0],C1,0,0,0), P0[6],P0[7],P0[8],P0[9],     pw0[2]=PKW(P0,4), pw0[3]=PKW(P0,6), pw0); \
    VRD(1); SBAR(); GAPA(C0=__builtin_amdgcn_mfma_f32_32x32x16_bf16(kf[2],qr[1],C0,0,0,0),   P0[10],P0[11],P0[12],P0[13], pw1[0]=PKW(P0,8), pw1[1]=PKW(P0,10), pw1); \
    VRD(5); SBAR(); GAPA(C1=__builtin_amdgcn_mfma_f32_32x32x16_bf16(kf[3],qr[1],C1,0,0,0),   P0[14],P0[15],P1[0],P1[1],   pw1[2]=PKW(P0,12),pw1[3]=PKW(P0,14), pw1); \
    VRD(2); SBAR(); GAPA(C0=__builtin_amdgcn_mfma_f32_32x32x16_bf16(kf[4],qr[2],C0,0,0,0),   P1[2],P1[3],P1[4],P1[5],     pw2[0]=PKW(P1,0), pw2[1]=PKW(P1,2), pw2); \
    VRD(6); SBAR(); GAPA(C1=__builtin_amdgcn_mfma_f32_32x32x16_bf16(kf[5],qr[2],C1,0,0,0),   P1[6],P1[7],P1[8],P1[9],     pw2[2]=PKW(P1,4), pw2[3]=PKW(P1,6), pw2); \
    VRD(3); SBAR(); GAPA(C0=__builtin_amdgcn_mfma_f32_32x32x16_bf16(kf[6],qr[3],C0,0,0,0),   P1[10],P1[11],P1[12],P1[13], pw3[0]=PKW(P1,8), pw3[1]=PKW(P1,10), pw3); \
    VRD(7); SBAR(); GAPA(C1=__builtin_amdgcn_mfma_f32_32x32x16_bf16(kf[7],qr[3],C1,0,0,0),   P1[14],P1[15],0.f,0.f,       pw3[2]=PKW(P1,12),pw3[3]=PKW(P1,14), pw3); \
    l_reg+=sacc; \
    if(GK){DMA_K((t)+3,sl_cur);} if(GV){DMA_V((t)+1,sl_next);} \
    CMASK(C0,C1,t); \
    { float a=MX3(C0[0],C0[1],C1[0]),b=MX3(C0[2],C0[3],C1[1]); a=MX3(a,C1[2],C1[3]); \
      _Pragma("unroll") for(int r=4;r<16;r+=4){a=MX3(a,C0[r],C0[r+1]);b=MX3(b,C0[r+2],C0[r+3]);a=MX3(a,C1[r],C1[r+1]);b=MX3(b,C1[r+2],C1[r+3]);} \
      float rm=__builtin_fmaxf(a,b); { auto rr=__builtin_amdgcn_permlane32_swap(__float_as_uint(rm),__float_as_uint(rm),false,false); rm=__builtin_fmaxf(__uint_as_float(rr[0]),__uint_as_float(rr[1])); } \
      resc=false; \
      if(__builtin_expect(__any(rm>(float)THRL),0)){ const float dl=__builtin_fmaxf(rm,0.f); mhat+=dl; \
        _Pragma("unroll") for(int r=0;r<16;++r){C0[r]-=dl;C1[r]-=dl;} \
        nb-=dl; \
        const float f=__builtin_amdgcn_exp2f(-dl); l_reg*=f; if(hi==0)wsf[r32]=f; resc=true; } } \
    SBAR(); \
    GAPB(o[0]=__builtin_amdgcn_mfma_f32_32x32x16_bf16(PAF(0),VFR(0),o[0],0,0,0), C0,0, NIN(GL,P0,(t)+1,0,0)); \
    GAPB(o[1]=__builtin_amdgcn_mfma_f32_32x32x16_bf16(PAF(0),VFR(4),o[1],0,0,0), C0,4, NIN(GL,P0,(t)+1,0,1)); \
    KRD(GL,0); GAPB(o[0]=__builtin_amdgcn_mfma_f32_32x32x16_bf16(PAF(1),VFR(1),o[0],0,0,0), C0,8, NIN(GL,P0,(t)+1,0,2)); \
    KRD(GL,1); GAPB(o[1]=__builtin_amdgcn_mfma_f32_32x32x16_bf16(PAF(1),VFR(5),o[1],0,0,0), C0,12, NIN(GL,P0,(t)+1,0,3)); \
    KRD(GL,2); GAPB(o[0]=__builtin_amdgcn_mfma_f32_32x32x16_bf16(PAF(2),VFR(2),o[0],0,0,0), C1,0, NIN(GL,P1,(t)+1,32,0)); \
    KRD(GL,3); GAPB(o[1]=__builtin_amdgcn_mfma_f32_32x32x16_bf16(PAF(2),VFR(6),o[1],0,0,0), C1,4, NIN(GL,P1,(t)+1,32,1)); \
    GAPB(o[0]=__builtin_amdgcn_mfma_f32_32x32x16_bf16(PAF(3),VFR(3),o[0],0,0,0), C1,8, NIN(GL,P1,(t)+1,32,2)); \
    GAPB(o[1]=__builtin_amdgcn_mfma_f32_32x32x16_bf16(PAF(3),VFR(7),o[1],0,0,0), C1,12, NIN(GL,P1,(t)+1,32,3)); \
    }while(0)
  int t=1;
  #undef CMASK
  #define CMASK(P0,P1,t) do{}while(0)
  for(;t+5<NT;t+=2){
    STEP(pB0,pB1,pA0,pA1,t,true,true,true);     WAIT_BAR(2); RESC(); ROT();
    STEP(pA0,pA1,pB0,pB1,t+1,true,true,true);   WAIT_BAR(2); RESC(); ROT();
  }
  #undef CMASK
  #define CMASK(P0,P1,t) do{int jb_=(t)-(NT-4); if(jb_>=0)cmask(P0,P1,jb_,qrel,hi);}while(0)
  #define ENDW(tt) do{ if((tt)+3<NT){WAIT_BAR(2);} else if((tt)+2<NT){WAIT_BAR(1);} else {WAIT_BAR(0);} }while(0)
  for(;t+1<NT;t+=2){
    STEP(pB0,pB1,pA0,pA1,t,(t+3<NT),(t+1<NT),(t+1<NT));       ENDW(t);   RESC(); ROT();
    STEP(pA0,pA1,pB0,pB1,t+1,(t+4<NT),(t+2<NT),(t+2<NT));     ENDW(t+1); RESC(); ROT();
  }
  STEP(pB0,pB1,pA0,pA1,NT-1,false,false,false); RESC();
  { float sacc=pB0[0]+pB0[1]; _Pragma("unroll") for(int r=2;r<16;++r)sacc+=pB0[r]; _Pragma("unroll") for(int r=0;r<16;++r)sacc+=pB1[r]; l_reg+=sacc;
    pw0=(u32x4){PKW(pB0,0),PKW(pB0,2),PKW(pB0,4),PKW(pB0,6)};pw1=(u32x4){PKW(pB0,8),PKW(pB0,10),PKW(pB0,12),PKW(pB0,14)};pw2=(u32x4){PKW(pB1,0),PKW(pB1,2),PKW(pB1,4),PKW(pB1,6)};pw3=(u32x4){PKW(pB1,8),PKW(pB1,10),PKW(pB1,12),PKW(pB1,14)};
    SBAR(); pv(o,vb0+sl_cur,PAF(0),PAF(1),PAF(2),PAF(3)); }
  #undef PKW
  #undef PAF
  #undef VFR
  #undef PIN
  #undef MX3
  #undef GAPA
  #undef GAPB
  #undef NIN
  #undef CINIT
  #undef CINIT4
  #undef EX
  #undef VRD
  #undef KRD
  #undef STEP
  #undef ENDW
  {auto rr=__builtin_amdgcn_permlane32_swap(__float_as_uint(l_reg),__float_as_uint(l_reg),false,false);l_reg=__uint_as_float(rr[0])+__uint_as_float(rr[1]);}
  if(hi==0)wsf[32+r32]=l_reg;asm volatile("s_waitcnt lgkmcnt(0)":::"memory");
  float rli[16];
  #pragma unroll
  for(int r=0;r<16;++r)rli[r]=__builtin_amdgcn_rcpf(wsf[32+crow(r,hi)]);
  { bf16*stg=(bf16*)(shm+LDS_OST)+wid*2048;
    #pragma unroll
    for(int r=0;r<16;++r){const int orow=crow(r,hi);
      #pragma unroll
      for(int d0=0;d0<2;++d0)stg[orow*64+d0*32+r32]=__float2bfloat16(o[d0][r]*rli[r]);}
    asm volatile("s_waitcnt lgkmcnt(0)":::"memory");
    const long grow0=rowbase+q0+wid*QBLK;
    #pragma unroll
    for(int i=0;i<4;++i){const int row=i*8+(lane>>3),ch=lane&7; const u32x4 v=*(const u32x4*)(stg+row*64+ch*8);
      const u32x4 g=*(const u32x4*)(shm+LDS_G+wid*4096+i*1024+lane*16); u32x4 w;
      w.x=cvtpk_s(bf_lo(v.x)*silu_f(bf_lo(g.x)),bf_hi(v.x)*silu_f(bf_hi(g.x))); w.y=cvtpk_s(bf_lo(v.y)*silu_f(bf_lo(g.y)),bf_hi(v.y)*silu_f(bf_hi(g.y)));
      w.z=cvtpk_s(bf_lo(v.z)*silu_f(bf_lo(g.z)),bf_hi(v.z)*silu_f(bf_hi(g.z))); w.w=cvtpk_s(bf_lo(v.w)*silu_f(bf_lo(g.w)),bf_hi(v.w)*silu_f(bf_hi(g.w)));
      *(u32x4*)(Y+(grow0+row)*1024+256+h*D+ch*8)=w;} }
  asm volatile("s_waitcnt lgkmcnt(0)\n\ts_barrier":::"memory");
  #undef DMA_K
  #undef DMA_V
  #undef CMASK
  #undef START
  #undef RESC
  #undef ROT
}
#undef SBAR
#undef WAIT_BAR
__device__ __forceinline__ int attn_skip(const Ctx& c, int l, int b, int h, int qb) {
    const unsigned* nrm = (const unsigned*)(c.ws + WS_NORM) + (size_t)l * 128; const float* Fbh = (const float*)(c.ws + WS_FCUM) + (size_t)(b * NHEAD + h) * SEQ;
    const float Bq = sqrtf(__uint_as_float(nrm[(b * NHEAD + h) * 2]) * __uint_as_float(nrm[(b * NHEAD + h) * 2 + 1]));
    const int q0 = qb * QB, NT0 = (q0 + QB) / KVBLK; const float fq0 = Fbh[q0];
    const bool cnd = (c.lane < NT0 - 4) && (2.f * Bq + fq0 - Fbh[64 * c.lane + 63] < -150.f);
    return __builtin_amdgcn_readfirstlane(__popcll(__ballot(cnd))) & ~1;
}
__device__ __forceinline__ void unit_of(int v, int i, int& b, int& h, int& qb) { const int hp = (v & 31) >> 3, j = v & 7; b = v >> 5; h = (i & 1) ? 7 - hp : hp; qb = (i == 0) ? j : (i == 1) ? 8 + j : (i == 2) ? 15 - j : 7 - j; }
__device__ __forceinline__ unsigned attn_skips(const Ctx& c, int l) {
    unsigned pk = 0u;
#pragma unroll
    for (int i = 0; i < 4; ++i) { int b, h, qb; unit_of(c.vcu, i, b, h, qb); pk |= (unsigned)attn_skip(c, l, b, h, qb) << (8 * i); }
    return pk;
}
__device__ __forceinline__ void attn_phase(const Ctx& c, int l, unsigned tspk) {
    for (int v = c.vcu; v < 256; v += c.G) {
#pragma unroll 1
        for (int i = 0; i < 4; ++i) { int b, h, qb; unit_of(v, i, b, h, qb);
            const int tsel = (int)((tspk >> (8 * i)) & 255u);
            const int ts = (v == c.vcu) ? tsel : attn_skip(c, l, b, h, qb);
            attn_unit<24>(b, h, qb, (const bf16*)(c.ws + WS_Z + 1 * ZARR), (const bf16*)(c.ws + WS_Z + 2 * ZARR), (const bf16*)(c.ws + WS_Z + 3 * ZARR),
                         (const unsigned short*)(c.ws + WS_Z + 4 * ZARR), (unsigned short*)(c.ws + WS_XB), (const float*)(c.ws + WS_FCUM), ts, (char*)c.lds); }
    }
}
}

#define LAS __attribute__((address_space(3)))
#define XB_TMO      128
#define XB_XCNT(j)  (256  + 64 * (j))
#define XB_XSUB(j)  (1280 + 64 * (j))
#define XB_XGEN(j)  (2304 + 64 * (j))
#define XB_TOP      3328
#define XB_TOPGEN   3392
#define XCD_BAR_WORDS 3456
#define XB_SPIN_CAP (1u << 18)

__device__ __forceinline__ unsigned xb_ld(unsigned* p)              { return __hip_atomic_load(p, __ATOMIC_RELAXED, __HIP_MEMORY_SCOPE_AGENT); }
__device__ __forceinline__ unsigned xb_add(unsigned* p, unsigned v) { return __hip_atomic_fetch_add(p, v, __ATOMIC_RELAXED, __HIP_MEMORY_SCOPE_AGENT); }
__device__ __forceinline__ unsigned xb_xcc_id() { return (unsigned)__builtin_amdgcn_s_getreg((3 << 11) | 20) & 0xFu; }
#define XB_SPIN(cond, bar) do { unsigned _sp = 0; while (cond) { __builtin_amdgcn_s_sleep(1); \
    if ((++_sp & 255u) == 0u) { if (xb_ld(&(bar)[XB_TMO])) break; if (_sp > XB_SPIN_CAP) { atomicAdd(&(bar)[XB_TMO], 1u); break; } } } } while (0)

struct XcdBarrier {
    unsigned* bar; unsigned x;
    volatile LAS unsigned* st;
};

__device__ __forceinline__ XcdBarrier xcd_barrier_post(unsigned* bar, volatile LAS unsigned* st) {
    XcdBarrier b; b.bar = bar; b.x = xb_xcc_id(); b.st = st;
    if (threadIdx.x == 0) (void)xb_add(&bar[XB_XCNT(b.x)], 1u);
    return b;
}
__device__ __forceinline__ void xcd_barrier_complete(unsigned* bar, unsigned x, unsigned& nloc, unsigned& nx) {
    const unsigned G = gridDim.x * gridDim.y * gridDim.z;
    unsigned sum, cnt, mine, sp = 0u;
    for (;;) {
        sum = 0u; cnt = 0u; mine = 0u;
#pragma unroll
        for (unsigned j = 0; j < 16; ++j) { const unsigned c = xb_ld(&bar[XB_XCNT(j)]); sum += c; cnt += (c > 0u) ? 1u : 0u; mine = (j == x) ? c : mine; }
        if (sum == G) break;
        __builtin_amdgcn_s_sleep(1);
        if ((++sp & 255u) == 0u) { if (xb_ld(&bar[XB_TMO])) break; if (sp > XB_SPIN_CAP) { atomicAdd(&bar[XB_TMO], 1u); break; } }
    }
    nloc = mine > 0u ? mine : 1u; nx = cnt > 0u ? cnt : 1u;
}

__device__ __forceinline__ void xcd_barrier(const XcdBarrier& b) {
    asm volatile("s_waitcnt vmcnt(0)" ::: "memory");
    __syncthreads();
    if (threadIdx.x == 0) {
        unsigned* bar = b.bar;
        __builtin_amdgcn_s_waitcnt(0);
        unsigned nloc = b.st[0], nx = b.st[1];
        if (nloc == 0u) { xcd_barrier_complete(bar, b.x, nloc, nx); b.st[0] = nloc; b.st[1] = nx; }
        const unsigned old = xb_add(&bar[XB_XSUB(b.x)], 1u);
        const unsigned gen = old / nloc;
        if (old + 1u == (gen + 1u) * nloc) {
            __builtin_amdgcn_fence(__ATOMIC_RELEASE, "agent");
            asm volatile("s_waitcnt vmcnt(0)" ::: "memory");
            const unsigned og = xb_add(&bar[XB_TOP], 1u);
            const unsigned tg = og / nx;
            if (og + 1u == (tg + 1u) * nx) xb_add(&bar[XB_TOPGEN], 1u);
            else XB_SPIN(xb_ld(&bar[XB_TOPGEN]) == tg, bar);
            __builtin_amdgcn_fence(__ATOMIC_ACQUIRE, "agent");
            xb_add(&bar[XB_XGEN(b.x)], 1u);
            asm volatile("s_waitcnt vmcnt(0)" ::: "memory");
        } else {
            XB_SPIN(xb_ld(&bar[XB_XGEN(b.x)]) == gen, bar);
            __builtin_amdgcn_fence(__ATOMIC_ACQUIRE, "agent");
            asm volatile("s_waitcnt vmcnt(0)" ::: "memory");
        }
    }
    __syncthreads();
}

constexpr int PH_PER_LAYER = 7, N_PHASES = NLAYER * PH_PER_LAYER + 1;
__global__ void __launch_bounds__(512, 2) mega_fwd(Args args) {
    __shared__ __attribute__((aligned(16))) unsigned char lds_raw[LDS_BYTES];
    cg::grid_group grid = cg::this_grid();
    Ctx c;
    c.a = &args; c.zero = 0;
    c.out = args.out; c.ws = args.ws; c.lds = lds_raw;
    c.tid = threadIdx.x; c.lane = c.tid & 63; c.wave = __builtin_amdgcn_readfirstlane(c.tid >> 6);
    c.G = gridDim.x; { const int bx = blockIdx.x; c.vcu = (c.G % 8 == 0) ? (bx % 8) * (c.G / 8) + bx / 8 : bx; }
    PG8_LAS unsigned char* lds3 = (PG8_LAS unsigned char*)lds_raw;
    volatile LAS unsigned* bst = (volatile LAS unsigned*)(lds3 + (LDS_BYTES - 64));
    if (threadIdx.x < 16) bst[threadIdx.x] = 0u;
    __syncthreads();
    XcdBarrier xbar = xcd_barrier_post((unsigned*)(args.ws), bst);
    grid.sync();
    bf16_t* XB = (bf16_t*)(c.ws + WS_XB);
    for (int ph = args.ph_lo; ph < args.ph_hi; ++ph) {
        const int l = ph / PH_PER_LAYER, k = ph % PH_PER_LAYER;
        { int t_ = threadIdx.x; asm volatile("" : "+v"(t_)); c.tid = t_; c.lane = t_ & 63; c.wave = __builtin_amdgcn_readfirstlane(t_ >> 6);
          int z_ = 0; asm volatile("" : "+s"(z_)); c.zero = z_;
          int bx = blockIdx.x; asm volatile("" : "+s"(bx)); c.vcu = (c.G % 8 == 0) ? (bx % 8) * (c.G / 8) + bx / 8 : bx; }
#ifndef REPMASK
#define REPMASK 0
#endif
#ifndef PHMASK
#define PHMASK 255
#endif
        if (k == 0) {
            if ((REPMASK & 512) && l < NLAYER) { phase_rows(c, 0); __syncthreads(); asm volatile("s_waitcnt vmcnt(0)" ::: "memory"); }
            if (PHMASK & 1) phase_rows(c, l);
        } else if (k == 1) {
            pg8::Gemm g{XB, (const bf16_t*)(c.ws + WS_WIN), MTOK, 6144, 1024}; pg8::StaticOrder S; S.init(MTOK, 6144, c.G, (int)blockIdx.x);
            pg8::EpiZ E{(bf16_t*)(c.ws + WS_Z), c.inp(IN_BIN) + (size_t)l * DIN};
            if (PHMASK & 2) pg8::gemm_phase<pg8::EpiZ, pg8::StaticOrder, true, true>(lds3, g, S, E);
            if (REPMASK & 2) { __syncthreads(); pg8::gemm_phase<pg8::EpiZ, pg8::StaticOrder, true, true>(lds3, g, S, E); }
        } else if (k == 2) {
            if (PHMASK & 4) { for (int tile = c.vcu; tile < 256; tile += c.G) norm_unit(c, l, tile);
            for (int bh = c.vcu; bh < 64; bh += c.G) fcum_unit(c, bh);
            for (int tile = c.vcu; tile < 256; tile += c.G) pool_tile(c, l, tile);
            ssm2_pass<false>(c, l); }
            if (REPMASK & 4) { __syncthreads(); for (int tile = c.vcu; tile < 256; tile += c.G) pool_tile(c, l, tile); }
            if (REPMASK & 16) { __syncthreads(); ssm2_pass<false>(c, l); }
        } else if (k == 3) {
            const unsigned tspk = fox2::attn_skips(c, l);
            if (PHMASK & 8) ssm2_pass<true>(c, l);
            if (REPMASK & 8) { __syncthreads(); ssm2_pass<true>(c, l); }
            __syncthreads();
#ifndef FOX_TUNED
#define FOX_TUNED 1
#endif
            if (PHMASK & 128) { if (FOX_TUNED) fox2::attn_phase(c, l, tspk); else fox::attn_phase(c); }
            if (REPMASK & 128) { __syncthreads(); fox2::attn_phase(c, l, tspk); }
        } else if (k == 4) {
            pg8::Gemm g{(const bf16_t*)(c.ws + WS_Z), (const bf16_t*)(c.ws + WS_WGLU), MTOK, 256, 256}; pg8::StaticOrder S; S.init(MTOK, 256, c.G, (int)blockIdx.x);
            pg8::EpiGlu E{(const bf16_t*)(c.ws + WS_Z), (const bf16_t*)(c.ws + WS_Z + 5 * ZARR), c.inp(IN_BGLU) + (size_t)l * 256, XB};
            if (PHMASK & 16) pg8::gemm_phase<pg8::EpiGlu, pg8::StaticOrder, true, true>(lds3, g, S, E);
            if (REPMASK & 256) { __syncthreads(); pg8::gemm_phase<pg8::EpiGlu, pg8::StaticOrder, true, true>(lds3, g, S, E); }
        } else if (k == 5) {
            pg8::Gemm g{XB, (const bf16_t*)(c.ws + WS_WUP), MTOK, 1024, 1024}; pg8::StaticOrder S; S.init(MTOK, 1024, c.G, (int)blockIdx.x);
            pg8::EpiUp E{(const bf16_t*)(c.ws + WS_Z + 6 * ZARR), (bf16_t*)(c.ws + WS_Z + 1 * ZARR)};
            int nrep_ = (REPMASK & 32) ? 2 : 1; asm volatile("" : "+s"(nrep_));
            for (int r_ = 0; r_ < nrep_; ++r_) { if (PHMASK & 32) pg8::gemm_phase<pg8::EpiUp, pg8::StaticOrder, true, true>(lds3, g, S, E); __syncthreads(); }
        } else {
            pg8::Gemm g{(const bf16_t*)(c.ws + WS_Z + 1 * ZARR), (const bf16_t*)(c.ws + WS_WOUT), MTOK, 1024, 1024}; pg8::StaticOrder S; S.init(MTOK, 1024, c.G, (int)blockIdx.x);
            pg8::EpiOut E{(l == 0) ? c.inp(IN_X) : (const float*)c.out, c.out, (l == 0) ? (const float*)nullptr : (const float*)(c.ws + WS_STATS),
                          c.inp(IN_LNG) + (size_t)(l > 0 ? l - 1 : 0) * DM, c.inp(IN_LNB) + (size_t)(l > 0 ? l - 1 : 0) * DM};
            if (PHMASK & 64) pg8::gemm_phase<pg8::EpiOut, pg8::StaticOrder, true, true>(lds3, g, S, E);
        }
        for (int rep_ = 0; rep_ < ((REPMASK & 64) ? 2 : 1); ++rep_)
        if (ph + 1 < args.ph_hi) {
            {
                xcd_barrier(xbar);
            }
        }
    }
}

extern "C" void kernel_launch(void* const* d_in, const int* in_sizes, int n_in, void* d_out, int out_size, void* d_ws, size_t ws_size, hipStream_t stream) {
    static int grid = 0;
    if (grid == 0) {
        if (n_in != 21 || out_size != MTOK * DM || ws_size < WS_END) { fprintf(stderr, "kernel_launch: unexpected shapes (n_in %d out %d ws %zu)\n", n_in, out_size, ws_size); grid = -1; return; }
        int dev = 0, cus = 0, per_cu = 0;
        (void)hipGetDevice(&dev); (void)hipDeviceGetAttribute(&cus, hipDeviceAttributeMultiprocessorCount, dev);
        if (hipOccupancyMaxActiveBlocksPerMultiprocessor(&per_cu, (const void*)mega_fwd, 512, 0) != hipSuccess || per_cu < 1) per_cu = 1;
        (void)hipGetLastError();
        grid = cus * per_cu;
    }
    if (grid < 0) return;
    (void)hipMemsetAsync(d_ws, 0, 16384, stream);
    Args a{};
    for (int i = 0; i < 21; ++i) a.in[i] = (const float*)d_in[i];
    a.out = (float*)d_out; a.ws = (unsigned char*)d_ws;
#if MK_ONE_LAUNCH
    a.ph_lo = 0; a.ph_hi = N_PHASES;
    void* kargs[] = {&a};
    hipError_t e = hipLaunchCooperativeKernel((const void*)mega_fwd, dim3(grid), dim3(512), kargs, 0, stream);
    if (e != hipSuccess) fprintf(stderr, "cooperative launch failed: %s (grid %d)\n", hipGetErrorString(e), grid);
#else
    for (int ph = 0; ph < N_PHASES; ++ph) { a.ph_lo = ph; a.ph_hi = ph + 1; hipLaunchKernelGGL(mega_fwd, dim3(grid), dim3(512), 0, stream, a); }
#endif
}
```

```cpp
#include <hip/hip_runtime.h>
#include <hip/hip_cooperative_groups.h>
#include <hip/hip_bf16.h>
#include <cstdio>
#include <cstdint>
namespace cg = cooperative_groups;

#ifndef MK_ONE_LAUNCH
#define MK_ONE_LAUNCH 1
#endif

constexpr int MTOK = 32768, DM = 1024, SEQ = 4096, NBATCH = 8, NHEAD = 8, DIN = 6152, NLAYER = 4;
constexpr float LOG2E = 1.4426950408889634f;
constexpr float QSCALE = 0.125f * 1.4426950408889634f;
constexpr float DN_ALPHA = 1.681792830507429f;
constexpr float LN_EPS = 1e-5f;

__device__ __forceinline__ float sigm(float v) { return __builtin_amdgcn_rcpf(1.0f + __builtin_amdgcn_exp2f(-LOG2E * v)); }
__device__ __forceinline__ float bf_lo(unsigned w) { return __uint_as_float(w << 16); }
__device__ __forceinline__ float bf_hi(unsigned w) { return __uint_as_float(w & 0xffff0000u); }

namespace pg8 {
#define PG8_LAS __attribute__((address_space(3)))
typedef unsigned short bf16_t;
typedef short bf16x8 __attribute__((ext_vector_type(8)));
typedef float f32x4 __attribute__((ext_vector_type(4)));
typedef unsigned u32x4 __attribute__((ext_vector_type(4)));
constexpr int BM = 256, BK = 64, HALF = 128, HTB = HALF * BK * 2  , STAGE_BYTES = 8 * HTB, NXCD = 8, WGM = 4;

__host__ __device__ __forceinline__ int lds_byte(int r, int c) { const int st = (r >> 4) * 2 + (c >> 5), rr = r & 15, cc = c & 31, ob = rr * 64 + cc * 2; return st * 1024 + (ob ^ (((ob >> 9) & 1) << 5)); }
__host__ __device__ __forceinline__ void stage_rc(int b, int& R, int& C) { const int st = b / 1024, sb = b % 1024, swz = sb ^ (((sb >> 9) & 1) << 5); R = (st >> 1) * 16 + swz / 64; C = (st & 1) * 32 + (swz % 64) / 2; }
__host__ __device__ __forceinline__ int perm32(int rho) { const int n = rho >> 4, i = rho & 15; return 8 * (i >> 2) + 4 * n + (i & 3); }

struct Unit { int pm, pn; };
struct Gemm { const bf16_t* A; const bf16_t* Bt; int M, N, K; };

struct StaticOrder {
    int nM, nN, nwg, G, c;
    __host__ __device__ void init(int M, int N, int G_, int c_) { nM = M / BM; nN = N / BM; nwg = nM * nN; G = G_; c = c_; }
    __host__ __device__ bool next(int i, Unit& u) const {
        const long L = (long)i * G + c; if (L >= nwg) return false;
        int wgid = (int)L; { const int q = nwg / NXCD, r = nwg % NXCD, xcd = wgid % NXCD, off = wgid / NXCD; wgid = (xcd < r ? xcd * (q + 1) : r * (q + 1) + (xcd - r) * q) + off; }
        const int nig = WGM * nN, gid = wgid / nig, fm = gid * WGM, gsz = (nM - fm) < WGM ? (nM - fm) : WGM;
        u.pm = fm + ((wgid % nig) % gsz); u.pn = (wgid % nig) / gsz; return true;
    }
    __device__ __forceinline__ void a_ready(const Unit&) const {}
    __device__ __forceinline__ void done(const Unit&) const {}
};


typedef float f32x2_t __attribute__((ext_vector_type(2))); typedef __bf16 bf16x2_t __attribute__((ext_vector_type(2)));
__device__ __forceinline__ unsigned cvt_pk_bf16(float lo, float hi) { f32x2_t v = {lo, hi}; bf16x2_t b = __builtin_convertvector(v, bf16x2_t); return __builtin_bit_cast(unsigned, b); }

template <int MODE> __device__ __forceinline__ float actf(float v) {
    if (MODE == 1) return v * sigm(v);
    if (MODE == 2) return fminf(1.0f + __builtin_amdgcn_exp2f(-LOG2E * v), 1e30f);
    if (MODE == 3) return v * QSCALE;
    return v;
}
#define EPI_FENCE() asm volatile("" ::: "memory")
#define EPI_LANE() int t__ = threadIdx.x; asm volatile("" : "+v"(t__)); const int wid__ = __builtin_amdgcn_readfirstlane(t__ >> 6); wr = wid__ >> 2; wc = wid__ & 3; fr = t__ & 15; fq = (t__ & 63) >> 4
struct EpiZ {
    static constexpr bool PERM = true, AFTER_DRAIN = false, HOOK = false, ACC_INIT = true;
    bf16_t* O; const float* bias;
    __device__ __forceinline__ void acc_init(f32x4 (&ini)[2][2], const Unit& u) const {
        int t__ = threadIdx.x; asm volatile("" : "+v"(t__)); const int wid__ = __builtin_amdgcn_readfirstlane(t__ >> 6), wc = wid__ & 3, fq = (t__ & 63) >> 4;
        const int pn = u.pn; const float* bp = bias + pn * BM + (pn >= 8 ? 8 : 0) + wc * 32 + 8 * fq;
#pragma unroll
        for (int bj = 0; bj < 2; ++bj)
#pragma unroll
            for (int n = 0; n < 2; ++n) ini[bj][n] = *(const f32x4*)(bp + bj * HALF + 4 * n);
    }
    template <int MODE> __device__ __forceinline__ void run(const f32x4 (&acc)[2][2][4][2], const Unit& u, int wr, int wc, int fr, int fq) const {
        EPI_LANE();
        const int pn = u.pn, colt = pn * BM, t = colt >> 9;
        char* base = (MODE == 2) ? (char*)(O + (size_t)6 * ((size_t)MTOK * 512)) + ((size_t)(((pn - 12) * 128 + u.pm) * 8 + wid__)) * 16384
                                 : (char*)(O + (size_t)t * ((size_t)MTOK * 512) + (size_t)u.pm * BM * 512 + (colt & 511));
        unsigned off0 = (MODE == 2) ? (unsigned)((t__ & 63) * 16) : (unsigned)((wr * 64 + fr) * 512 + wc * 32 + 8 * fq) * 2u; asm volatile("" : "+v"(off0));
#pragma unroll
        for (int bj = 0; bj < 2; ++bj) {
#pragma unroll
            for (int ai = 0; ai < 2; ++ai)
#pragma unroll
                for (int m = 0; m < 4; ++m) { const unsigned off = off0 + ((MODE == 2) ? (unsigned)(((ai * 4 + m) * 2 + bj) * 1024) : (unsigned)((ai * HALF + m * 16) * 512 + bj * HALF) * 2u);
                    const f32x4 v0 = acc[ai][bj][m][0], v1 = acc[ai][bj][m][1];
                    u32x4 w; w.x = cvt_pk_bf16(actf<MODE>(v0[0]), actf<MODE>(v0[1])); w.y = cvt_pk_bf16(actf<MODE>(v0[2]), actf<MODE>(v0[3]));
                    w.z = cvt_pk_bf16(actf<MODE>(v1[0]), actf<MODE>(v1[1])); w.w = cvt_pk_bf16(actf<MODE>(v1[2]), actf<MODE>(v1[3]));
                    *(u32x4*)(base + off) = w; }
            EPI_FENCE();
        }
    }
    __device__ __forceinline__ void operator()(const f32x4 (&acc)[2][2][4][2], const Unit& u, int wr, int wc, int fr, int fq) const {
        const int pn = u.pn;
        if (pn >= 12) run<2>(acc, u, wr, wc, fr, fq);
        else if (pn == 1 || pn == 8 || pn == 9 || pn == 11) run<1>(acc, u, wr, wc, fr, fq);
        else if (pn == 2 || pn == 3) run<3>(acc, u, wr, wc, fr, fq);
        else run<0>(acc, u, wr, wc, fr, fq);
    }
};
struct EpiGlu {
    static constexpr bool PERM = true, AFTER_DRAIN = false, HOOK = false, ACC_INIT = true;
    const bf16_t* YG; const bf16_t* ZC; const float* bias; bf16_t* Y;
    __device__ __forceinline__ void acc_init(f32x4 (&ini)[2][2], const Unit& u) const {
        int t__ = threadIdx.x; asm volatile("" : "+v"(t__)); const int wid__ = __builtin_amdgcn_readfirstlane(t__ >> 6), wc = wid__ & 3, fq = (t__ & 63) >> 4;
        const float* bp = bias + wc * 32 + 8 * fq; (void)u;
#pragma unroll
        for (int bj = 0; bj < 2; ++bj)
#pragma unroll
            for (int n = 0; n < 2; ++n) ini[bj][n] = *(const f32x4*)(bp + bj * HALF + 4 * n);
    }
    __device__ __forceinline__ void operator()(const f32x4 (&acc)[2][2][4][2], const Unit& u, int wr, int wc, int fr, int fq) const {
        EPI_LANE();
        const char* ygb = (const char*)(YG + (size_t)u.pm * BM * 256); const char* sgb = (const char*)(ZC + (size_t)u.pm * BM * 512 + 256); char* yb = (char*)(Y + (size_t)u.pm * BM * 1024 + 768);
        unsigned rl0 = (unsigned)(wr * 64 + fr), col0 = (unsigned)(wc * 32 + 8 * fq); asm volatile("" : "+v"(rl0), "+v"(col0));
#pragma unroll
        for (int bj = 0; bj < 2; ++bj) { const unsigned col = col0 + bj * HALF;
#pragma unroll
            for (int ai = 0; ai < 2; ++ai) {
                u32x4 ygv[4], sgv[4];
#pragma unroll
                for (int m = 0; m < 4; ++m) { const unsigned rl = rl0 + (unsigned)(ai * HALF + m * 16);
                    ygv[m] = *(const u32x4*)(ygb + (rl * 256u + col) * 2u); sgv[m] = *(const u32x4*)(sgb + (rl * 512u + col) * 2u); }
#pragma unroll
                for (int m = 0; m < 4; ++m) { const unsigned rl = rl0 + (unsigned)(ai * HALF + m * 16);
                    const u32x4 yg = ygv[m], sg = sgv[m];
                    const f32x4 v0 = acc[ai][bj][m][0], v1 = acc[ai][bj][m][1];
                    u32x4 w;
                    w.x = cvt_pk_bf16(bf_lo(yg.x) * sigm(v0[0]) * bf_lo(sg.x), bf_hi(yg.x) * sigm(v0[1]) * bf_hi(sg.x));
                    w.y = cvt_pk_bf16(bf_lo(yg.y) * sigm(v0[2]) * bf_lo(sg.y), bf_hi(yg.y) * sigm(v0[3]) * bf_hi(sg.y));
                    w.z = cvt_pk_bf16(bf_lo(yg.z) * sigm(v1[0]) * bf_lo(sg.z), bf_hi(yg.z) * sigm(v1[1]) * bf_hi(sg.z));
                    w.w = cvt_pk_bf16(bf_lo(yg.w) * sigm(v1[2]) * bf_lo(sg.w), bf_hi(yg.w) * sigm(v1[3]) * bf_hi(sg.w));
                    *(u32x4*)(yb + (rl * 1024u + col) * 2u) = w; }
                asm volatile("" : "+v"(rl0), "+v"(col0) :: "memory"); } }
    }
};
struct EpiUp {
    static constexpr bool PERM = true, AFTER_DRAIN = false, HOOK = true, ACC_INIT = false;
    const bf16_t* G; bf16_t* Mg;
    __device__ __forceinline__ const char* gbase(int br, const Unit& u, int wid) const { return (const char*)G + ((size_t)(((br * 4 + u.pn) * 128 + u.pm) * 8 + wid)) * 16384; }
    __device__ __forceinline__ void hook(f32x4 (&acc)[2][2][4][2], const Unit& u, int which, int wr, int wc, int fr, int fq) const {
        EPI_LANE();
        const char* gn_b = gbase(which, u, wid__); const char* gd_b = gbase(which + 1, u, wid__);
        unsigned off0 = (unsigned)((t__ & 63) * 16); asm volatile("" : "+v"(off0));
#pragma unroll
        for (int ai = 0; ai < 2; ++ai) {
                u32x4 gnv[4][2], gdv[4][2];
#pragma unroll
                for (int m = 0; m < 4; ++m)
#pragma unroll
                    for (int bj = 0; bj < 2; ++bj) { const unsigned off = off0 + (unsigned)(((ai * 4 + m) * 2 + bj) * 1024);
                        gnv[m][bj] = *(const u32x4*)(gn_b + off); gdv[m][bj] = *(const u32x4*)(gd_b + off); }
#pragma unroll
                for (int m = 0; m < 4; ++m)
#pragma unroll
                    for (int bj = 0; bj < 2; ++bj) { const u32x4 gn = gnv[m][bj], gd = gdv[m][bj];
#define RT(a, b) ((b) * __builtin_amdgcn_rcpf(a))
                        f32x4 r0, r1;
                        r0[0] = RT(bf_lo(gn.x), bf_lo(gd.x)); r0[1] = RT(bf_hi(gn.x), bf_hi(gd.x)); r0[2] = RT(bf_lo(gn.y), bf_lo(gd.y)); r0[3] = RT(bf_hi(gn.y), bf_hi(gd.y));
                        r1[0] = RT(bf_lo(gn.z), bf_lo(gd.z)); r1[1] = RT(bf_hi(gn.z), bf_hi(gd.z)); r1[2] = RT(bf_lo(gn.w), bf_lo(gd.w)); r1[3] = RT(bf_hi(gn.w), bf_hi(gd.w));
#undef RT
                        acc[ai][bj][m][0] *= r0; acc[ai][bj][m][1] *= r1; }
                asm volatile("" : "+v"(off0) :: "memory"); }
    }
    __device__ __forceinline__ void operator()(const f32x4 (&acc)[2][2][4][2], const Unit& u, int wr, int wc, int fr, int fq) const {
        EPI_LANE();
        const char* g_b = gbase(2, u, wid__) + (t__ & 63) * 16; char* mb = (char*)(Mg + (size_t)u.pm * BM * 1024 + u.pn * BM);
        unsigned rl0 = (unsigned)(wr * 64 + fr), cl0 = (unsigned)(wc * 32 + 8 * fq); asm volatile("" : "+v"(rl0), "+v"(cl0));
#pragma unroll
        for (int ai = 0; ai < 2; ++ai) {
            u32x4 gv[4][2];
#pragma unroll
            for (int m = 0; m < 4; ++m)
#pragma unroll
                for (int bj = 0; bj < 2; ++bj) gv[m][bj] = *(const u32x4*)(g_b + ((ai * 4 + m) * 2 + bj) * 1024);
#pragma unroll
            for (int m = 0; m < 4; ++m) { const unsigned rl = rl0 + (unsigned)(ai * HALF + m * 16);
#pragma unroll
                for (int bj = 0; bj < 2; ++bj) { const unsigned cl = cl0 + (unsigned)(bj * HALF);
                    const u32x4 g = gv[m][bj];
                    const f32x4 v0 = acc[ai][bj][m][0], v1 = acc[ai][bj][m][1];
                    u32x4 w;
                    w.x = cvt_pk_bf16(v0[0] * __builtin_amdgcn_rcpf(bf_lo(g.x)), v0[1] * __builtin_amdgcn_rcpf(bf_hi(g.x)));
                    w.y = cvt_pk_bf16(v0[2] * __builtin_amdgcn_rcpf(bf_lo(g.y)), v0[3] * __builtin_amdgcn_rcpf(bf_hi(g.y)));
                    w.z = cvt_pk_bf16(v1[0] * __builtin_amdgcn_rcpf(bf_lo(g.z)), v1[1] * __builtin_amdgcn_rcpf(bf_hi(g.z)));
                    w.w = cvt_pk_bf16(v1[2] * __builtin_amdgcn_rcpf(bf_lo(g.w)), v1[3] * __builtin_amdgcn_rcpf(bf_hi(g.w)));
                    *(u32x4*)(mb + (rl * 1024u + cl) * 2u) = w; } }
            asm volatile("" : "+v"(rl0), "+v"(cl0) :: "memory"); }
    }
};
struct EpiOut {
    static constexpr bool PERM = false, AFTER_DRAIN = false, HOOK = false, ACC_INIT = false;
    const float* base; float* out; const float* stats; const float* lng; const float* lnb;
    __device__ __forceinline__ void operator()(const f32x4 (&acc)[2][2][4][2], const Unit& u, int wr, int wc, int fr, int fq) const {
        EPI_LANE();
        const size_t tile = (size_t)u.pm * BM * 1024 + u.pn * BM;
        const char* bb = (const char*)(base + tile); char* ob = (char*)(out + tile);
        unsigned off0 = (unsigned)((wr * 64 + fr) * 1024 + wc * 32 + 4 * fq) * 4u; asm volatile("" : "+v"(off0));
        if (stats == nullptr) {
#pragma unroll
            for (int ai = 0; ai < 2; ++ai) {
                f32x4 bs[4][2][2];
#pragma unroll
                for (int m = 0; m < 4; ++m)
#pragma unroll
                    for (int bj = 0; bj < 2; ++bj)
#pragma unroll
                        for (int n = 0; n < 2; ++n) bs[m][bj][n] = *(const f32x4*)(bb + off0 + (unsigned)((ai * HALF + m * 16) * 1024 + bj * HALF + n * 16) * 4u);
#pragma unroll
                for (int m = 0; m < 4; ++m)
#pragma unroll
                    for (int bj = 0; bj < 2; ++bj)
#pragma unroll
                        for (int n = 0; n < 2; ++n) *(f32x4*)(ob + off0 + (unsigned)((ai * HALF + m * 16) * 1024 + bj * HALF + n * 16) * 4u) = bs[m][bj][n] * DN_ALPHA + acc[ai][bj][m][n];
                asm volatile("" : "+v"(off0) :: "memory"); }
        } else {
            const char* sp = (const char*)(stats + (size_t)u.pm * BM * 2);
            unsigned soff0 = (unsigned)(wr * 64 + fr) * 8u, coff0 = (unsigned)(u.pn * BM + wc * 32 + 4 * fq) * 4u; asm volatile("" : "+v"(soff0), "+v"(coff0));
            f32x4 gv[2][2], bv[2][2];
#pragma unroll
            for (int bj = 0; bj < 2; ++bj)
#pragma unroll
                for (int n = 0; n < 2; ++n) { gv[bj][n] = *(const f32x4*)((const char*)lng + coff0 + (unsigned)(bj * HALF + n * 16) * 4u); bv[bj][n] = *(const f32x4*)((const char*)lnb + coff0 + (unsigned)(bj * HALF + n * 16) * 4u); }
#pragma unroll
            for (int ai = 0; ai < 2; ++ai)
#pragma unroll
                for (int mh = 0; mh < 2; ++mh) {
                    f32x4 bs[2][2][2]; f32x2_t st[2];
#pragma unroll
                    for (int mm = 0; mm < 2; ++mm) { st[mm] = *(const f32x2_t*)(sp + soff0 + (unsigned)(ai * HALF + (2 * mh + mm) * 16) * 8u);
#pragma unroll
                        for (int bj = 0; bj < 2; ++bj)
#pragma unroll
                            for (int n = 0; n < 2; ++n) bs[mm][bj][n] = *(const f32x4*)(bb + off0 + (unsigned)((ai * HALF + (2 * mh + mm) * 16) * 1024 + bj * HALF + n * 16) * 4u); }
#pragma unroll
                    for (int mm = 0; mm < 2; ++mm)
#pragma unroll
                        for (int bj = 0; bj < 2; ++bj)
#pragma unroll
                            for (int n = 0; n < 2; ++n) { const f32x4 hv = ((bs[mm][bj][n] - st[mm][0]) * st[mm][1]) * gv[bj][n] + bv[bj][n];
                                *(f32x4*)(ob + off0 + (unsigned)((ai * HALF + (2 * mh + mm) * 16) * 1024 + bj * HALF + n * 16) * 4u) = hv * DN_ALPHA + acc[ai][bj][2 * mh + mm][n]; }
                    asm volatile("" : "+v"(off0), "+v"(soff0) :: "memory"); }
        }
    }
};

template <class Epi, class Sched, bool ALIGN_EPI = false, bool SP2 = false>
__device__ __forceinline__ void gemm_phase(PG8_LAS unsigned char* lds, const Gemm g, const Sched& S, const Epi& E) {
    int tid_ = threadIdx.x; asm volatile("" : "+v"(tid_));
    const int tid = tid_, wid = __builtin_amdgcn_readfirstlane(tid >> 6), lane = tid & 63, wr = wid >> 2, wc = wid & 3, fr = lane & 15, fq = lane >> 4;
    int K_ = g.K; asm volatile("" : "+s"(K_));
    const int K = K_, nt = K / BK;
    unsigned voffA[2], voffB[2];
#pragma unroll
    for (int i = 0; i < 2; ++i) { int R, C; stage_rc(tid * 16 + i * 8192, R, C); const int Rb = Epi::PERM ? ((R & ~31) + perm32(R & 31)) : R;
        voffA[i] = (unsigned)(R * K + C) * 2u; voffB[i] = (unsigned)(Rb * K + C) * 2u; }
    const size_t kstep = (size_t)(BK * 2);
    const size_t hstep = (size_t)HALF * K * 2;
    const size_t tstep = 2 * hstep;
    const unsigned ldsw = (unsigned)wid * 1024u;
    const int aoff = lds_byte(wr * 64 + fr, fq * 8), boff = lds_byte(wc * 32 + fr, fq * 8);
#define PG8_SA(b, h) (((b) * 2 + (h)) * HTB)
#define PG8_SB(b, h) ((4 + (b) * 2 + (h)) * HTB)
#define PG8_STAGE(bufoff, gbase, voff) do { _Pragma("unroll") for (int _i = 0; _i < 2; ++_i) \
        __builtin_amdgcn_global_load_lds((const unsigned*)((const char*)(gbase) + (voff)[_i]), (PG8_LAS unsigned*)(lds + (bufoff) + ldsw + _i * 8192), 16, 0, 0); } while (0)
#define PG8_LDA(dst, b, h) do { _Pragma("unroll") for (int m = 0; m < 4; ++m) _Pragma("unroll") for (int k = 0; k < 2; ++k) dst[m][k] = *(const PG8_LAS bf16x8*)(lds + PG8_SA(b, h) + aoff + m * 2048 + k * 1024); } while (0)
#define PG8_LDB(dst, b, h) do { _Pragma("unroll") for (int n = 0; n < 2; ++n) _Pragma("unroll") for (int k = 0; k < 2; ++k) dst[n][k] = *(const PG8_LAS bf16x8*)(lds + PG8_SB(b, h) + boff + n * 2048 + k * 1024); } while (0)
#define PG8_MMA(ai, bj, At, Bt) do { __builtin_amdgcn_s_setprio(1); _Pragma("unroll") for (int m = 0; m < 4; ++m) _Pragma("unroll") for (int n = 0; n < 2; ++n) _Pragma("unroll") for (int k = 0; k < 2; ++k) \
        acc[ai][bj][m][n] = __builtin_amdgcn_mfma_f32_16x16x32_bf16(Bt[n][k], At[m][k], acc[ai][bj][m][n], 0, 0, 0); __builtin_amdgcn_s_setprio(0); } while (0)
#define PG8_WAIT_V(n) asm volatile("s_waitcnt vmcnt(" #n ")" ::: "memory")
#define PG8_WAIT_L(n) asm volatile("s_waitcnt lgkmcnt(" #n ")" ::: "memory")
#define PG8_BAR __builtin_amdgcn_s_barrier()
#define PG8_SCHED __builtin_amdgcn_sched_barrier(0)
    Unit cur, nxt; int ui = 0;
    if (!S.next(0, cur)) return;
    f32x4 acc[2][2][4][2];
    f32x4 ini[2][2];
#pragma unroll
    for (int b = 0; b < 2; ++b)
#pragma unroll
        for (int n = 0; n < 2; ++n) ini[b][n] = (f32x4){0.f, 0.f, 0.f, 0.f};
    if constexpr (Epi::ACC_INIT) E.acc_init(ini, cur);
#pragma unroll
    for (int a = 0; a < 2; ++a)
#pragma unroll
        for (int b = 0; b < 2; ++b)
#pragma unroll
            for (int m = 0; m < 4; ++m)
#pragma unroll
                for (int n = 0; n < 2; ++n) acc[a][b][m][n] = ini[b][n];
    bf16x8 At[4][2], B0[2][2], B1[2][2];
    const char* cA = (const char*)g.A + (size_t)cur.pm * tstep; const char* cB = (const char*)g.Bt + (size_t)cur.pn * tstep;
    S.a_ready(cur);
    if constexpr (SP2) {
        PG8_STAGE(PG8_SB(0, 0), cB, voffB); PG8_STAGE(PG8_SB(0, 1), cB + hstep, voffB); PG8_STAGE(PG8_SA(0, 0), cA, voffA); PG8_STAGE(PG8_SA(0, 1), cA + hstep, voffA);
        if (wr == 1) PG8_BAR;
        PG8_WAIT_V(2); PG8_BAR;
        PG8_STAGE(PG8_SB(1, 0), cB + kstep, voffB); PG8_STAGE(PG8_SA(1, 0), cA + kstep, voffA); PG8_STAGE(PG8_SB(1, 1), cB + hstep + kstep, voffB);
        PG8_WAIT_V(6); PG8_BAR;
    } else {
        PG8_STAGE(PG8_SB(0, 0), cB, voffB); PG8_STAGE(PG8_SA(0, 0), cA, voffA); PG8_STAGE(PG8_SB(0, 1), cB + hstep, voffB); PG8_STAGE(PG8_SA(0, 1), cA + hstep, voffA);
        if (wr == 1) PG8_BAR;
        PG8_WAIT_V(4); PG8_BAR;
        PG8_STAGE(PG8_SB(1, 0), cB + kstep, voffB); PG8_STAGE(PG8_SA(1, 0), cA + kstep, voffA); PG8_STAGE(PG8_SB(1, 1), cB + hstep + kstep, voffB);
        PG8_WAIT_V(6); PG8_BAR;
    }
    for (;;) {
        const bool has_next = S.next(ui + 1, nxt);
        const char* nA = has_next ? (const char*)g.A + (size_t)nxt.pm * tstep : cA; const char* nB = has_next ? (const char*)g.Bt + (size_t)nxt.pn * tstep : cB;
        for (int t = 0; t < nt; t += 2) {
            if constexpr (Epi::HOOK) { if (t == 4 || t == 12) { if (wr == 0) PG8_BAR; PG8_SCHED; E.hook(acc, cur, t == 4 ? 0 : 1, wr, wc, fr, fq); asm volatile("" ::: "memory"); PG8_SCHED; if (wr == 1) PG8_BAR; } }
            const bool last = (t == nt - 2);
            const char* a1 = cA + (size_t)(t + 1) * kstep;
            const char* a2 = last ? nA : cA + (size_t)(t + 2) * kstep; const char* b2 = last ? nB : cB + (size_t)(t + 2) * kstep;
            const char* a3 = a2 + kstep; const char* b3 = b2 + kstep;
            if (last && has_next) S.a_ready(nxt);
            if constexpr (SP2) {
            PG8_LDB(B0, 0, 0); PG8_LDB(B1, 0, 1); PG8_SCHED; PG8_LDA(At, 0, 0); PG8_STAGE(PG8_SA(1, 1), a1 + hstep, voffA);
            PG8_WAIT_V(8); PG8_WAIT_L(0); PG8_BAR; PG8_MMA(0, 0, At, B0); PG8_MMA(0, 1, At, B1); PG8_BAR; PG8_SCHED;
            PG8_LDA(At, 0, 1); PG8_STAGE(PG8_SB(0, 0), b2, voffB); PG8_STAGE(PG8_SB(0, 1), b2 + hstep, voffB); PG8_STAGE(PG8_SA(0, 0), a2, voffA);
            PG8_WAIT_V(8); PG8_WAIT_L(0); PG8_BAR; PG8_MMA(1, 0, At, B0); PG8_MMA(1, 1, At, B1); PG8_BAR; PG8_SCHED;
            PG8_LDB(B0, 1, 0); PG8_LDB(B1, 1, 1); PG8_SCHED; PG8_LDA(At, 1, 0); PG8_STAGE(PG8_SA(0, 1), a2 + hstep, voffA);
            PG8_WAIT_V(8); PG8_WAIT_L(0); PG8_BAR; PG8_MMA(0, 0, At, B0); PG8_MMA(0, 1, At, B1); PG8_BAR; PG8_SCHED;
            PG8_LDA(At, 1, 1); PG8_STAGE(PG8_SB(1, 0), b3, voffB); PG8_STAGE(PG8_SB(1, 1), b3 + hstep, voffB); PG8_STAGE(PG8_SA(1, 0), a3, voffA);
            PG8_WAIT_V(8); PG8_WAIT_L(0); PG8_BAR; PG8_MMA(1, 0, At, B0); PG8_MMA(1, 1, At, B1); PG8_BAR; PG8_SCHED;
            } else {
            PG8_LDB(B0, 0, 0); PG8_SCHED; PG8_LDA(At, 0, 0); PG8_STAGE(PG8_SA(1, 1), a1 + hstep, voffA);
            PG8_WAIT_L(8); PG8_BAR; PG8_WAIT_L(0); PG8_MMA(0, 0, At, B0); PG8_BAR; PG8_SCHED;
            PG8_LDB(B1, 0, 1); PG8_STAGE(PG8_SB(0, 0), b2, voffB);
            PG8_BAR; PG8_WAIT_L(0); PG8_MMA(0, 1, At, B1); PG8_BAR;
            PG8_LDA(At, 0, 1); PG8_STAGE(PG8_SA(0, 0), a2, voffA);
            PG8_BAR; PG8_WAIT_L(0); PG8_MMA(1, 0, At, B0); PG8_BAR; PG8_SCHED;
            PG8_STAGE(PG8_SB(0, 1), b2 + hstep, voffB);
            PG8_WAIT_V(6); PG8_BAR; PG8_MMA(1, 1, At, B1); PG8_BAR;
            PG8_LDB(B0, 1, 0); PG8_SCHED; PG8_LDA(At, 1, 0); PG8_STAGE(PG8_SA(0, 1), a2 + hstep, voffA);
            PG8_WAIT_L(8); PG8_BAR; PG8_WAIT_L(0); PG8_MMA(0, 0, At, B0); PG8_BAR; PG8_SCHED;
            PG8_LDB(B1, 1, 1); PG8_STAGE(PG8_SB(1, 0), b3, voffB);
            PG8_BAR; PG8_WAIT_L(0); PG8_MMA(0, 1, At, B1); PG8_BAR;
            PG8_LDA(At, 1, 1); PG8_STAGE(PG8_SA(1, 0), a3, voffA);
            PG8_BAR; PG8_WAIT_L(0); PG8_MMA(1, 0, At, B0); PG8_BAR; PG8_SCHED;
            PG8_STAGE(PG8_SB(1, 1), b3 + hstep, voffB);
            PG8_WAIT_V(6); PG8_BAR; PG8_MMA(1, 1, At, B1); PG8_BAR;
            }
        }
        if constexpr (ALIGN_EPI) { if (wr == 0) PG8_BAR; }
        if constexpr (!Epi::AFTER_DRAIN) { E(acc, cur, wr, wc, fr, fq); S.done(cur); }
        if (!has_next) break;
        if constexpr (Epi::ACC_INIT) E.acc_init(ini, nxt);
#pragma unroll
        for (int a = 0; a < 2; ++a)
#pragma unroll
            for (int b = 0; b < 2; ++b)
#pragma unroll
                for (int m = 0; m < 4; ++m)
#pragma unroll
                    for (int n = 0; n < 2; ++n) acc[a][b][m][n] = ini[b][n];
        cur = nxt; cA = nA; cB = nB; ++ui;
        if constexpr (ALIGN_EPI) { if (wr == 1) PG8_BAR; }
    }
    PG8_WAIT_V(0);
    if constexpr (!ALIGN_EPI) { if (wr == 0) PG8_BAR; }
    PG8_BAR;
    if constexpr (Epi::AFTER_DRAIN) { E.fused(acc, cur, wr, wc, fr, fq, lds, wid, lane); S.done(cur); }
#undef PG8_SA
#undef PG8_SB
#undef PG8_STAGE
#undef PG8_LDA
#undef PG8_LDB
#undef PG8_MMA
#undef PG8_WAIT_V
#undef PG8_WAIT_L
#undef PG8_BAR
#undef PG8_SCHED
}
}

constexpr size_t MiB = 1u << 20;
constexpr size_t WS_FLOG = 1 * MiB;
constexpr size_t WS_FCUM = 2 * MiB;
constexpr size_t WS_NORM = 14336;
constexpr size_t WS_SEND = 3 * MiB;
constexpr size_t WS_STATS = 4 * MiB;
constexpr size_t WS_WIN = 8 * MiB;
constexpr size_t WS_WUP = 20 * MiB;
constexpr size_t WS_WOUT = 22 * MiB;
constexpr size_t WS_WGLU = 24 * MiB;
constexpr size_t WS_Z = 32 * MiB;
constexpr size_t ZARR = 32 * MiB;
constexpr size_t WS_XB = 416 * MiB;
constexpr size_t WS_END = 480 * MiB;
constexpr int LDS_BYTES = 147456;

typedef unsigned short bf16_t;
typedef float f32x4 __attribute__((ext_vector_type(4)));
typedef float f32x16 __attribute__((ext_vector_type(16)));
typedef unsigned u32x4 __attribute__((ext_vector_type(4)));
typedef unsigned u32x2 __attribute__((ext_vector_type(2)));
typedef short bf16x8 __attribute__((ext_vector_type(8)));
typedef short s16x4 __attribute__((ext_vector_type(4)));

struct Args { const float* in[21]; float* out; unsigned char* ws; int ph_lo, ph_hi; };
struct Ctx {
    const Args* a; int zero; float* out; unsigned char* ws; unsigned char* lds;
    int tid, lane, wave, vcu, G;
    __device__ __forceinline__ const float* inp(int i) const { return a->in[i + zero]; }
};
#define IN_X 0
#define IN_WIN 1
#define IN_BIN 2
#define IN_POOLW 3
#define IN_POOLS 4
#define IN_ARE 5
#define IN_AIM 6
#define IN_LOGDT 7
#define IN_BRE 8
#define IN_BIM 9
#define IN_CRE 10
#define IN_CIM 11
#define IN_DSKIP 12
#define IN_WGLU 13
#define IN_BGLU 14
#define IN_WUPA 15
#define IN_WUPB 16
#define IN_WUPC 17
#define IN_WOUT 18
#define IN_LNG 19
#define IN_LNB 20

__device__ __forceinline__ unsigned pk_bf16(float lo, float hi) { return pg8::cvt_pk_bf16(lo, hi); }
__device__ __forceinline__ float wave_sum(float v) {
    v += __int_as_float(__builtin_amdgcn_update_dpp(0, __float_as_int(v), 0xB1, 0xf, 0xf, true));
    v += __int_as_float(__builtin_amdgcn_update_dpp(0, __float_as_int(v), 0x4E, 0xf, 0xf, true));
    v += __int_as_float(__builtin_amdgcn_update_dpp(0, __float_as_int(v), 0x141, 0xf, 0xf, true));
    v += __int_as_float(__builtin_amdgcn_update_dpp(0, __float_as_int(v), 0x140, 0xf, 0xf, true));
    const int iv = __float_as_int(v);
    const float r0 = __int_as_float(__builtin_amdgcn_readlane(iv, 0)), r1 = __int_as_float(__builtin_amdgcn_readlane(iv, 16)), r2 = __int_as_float(__builtin_amdgcn_readlane(iv, 32)), r3 = __int_as_float(__builtin_amdgcn_readlane(iv, 48));
    return (r0 + r1) + (r2 + r3);
}
#define LDS_FENCE() asm volatile("s_waitcnt lgkmcnt(0)" ::: "memory")

__device__ __forceinline__ void transpose_item(const float* Wsrc, int ldw, bf16_t* WT, int ldt, int kb, int nb, float* scr, int lane) {
    const int k0 = 64 * kb, n0 = 32 * nb;
#pragma unroll
    for (int i = 0; i < 8; ++i) { const int kk = 8 * i + (lane >> 3), n4 = 4 * (lane & 7);
        const f32x4 v = *(const f32x4*)(Wsrc + (size_t)(k0 + kk) * ldw + n0 + n4);
        scr[kk * 33 + n4] = v[0]; scr[kk * 33 + n4 + 1] = v[1]; scr[kk * 33 + n4 + 2] = v[2]; scr[kk * 33 + n4 + 3] = v[3]; }
    LDS_FENCE();
    const int c = lane & 7;
#pragma unroll
    for (int j = 0; j < 4; ++j) { const int n = (lane >> 3) + 8 * j; const float* s = scr + (8 * c) * 33 + n;
        u32x4 o; o.x = pk_bf16(s[0 * 33], s[1 * 33]); o.y = pk_bf16(s[2 * 33], s[3 * 33]); o.z = pk_bf16(s[4 * 33], s[5 * 33]); o.w = pk_bf16(s[6 * 33], s[7 * 33]);
        *(u32x4*)(WT + (size_t)(n0 + n) * ldt + k0 + 8 * c) = o; }
    LDS_FENCE();
}
__device__ __forceinline__ void phase_rows(const Ctx& c, int l) {
    const int gw = c.vcu * 8 + c.wave, NGW = c.G * 8, lane = c.lane;
    if (l < NLAYER) {
        float* scr = (float*)(c.lds + c.wave * 16384);
        bf16_t* Win_t = (bf16_t*)(c.ws + WS_WIN); bf16_t* Wup_t = (bf16_t*)(c.ws + WS_WUP); bf16_t* Wout_t = (bf16_t*)(c.ws + WS_WOUT); bf16_t* Wglu_t = (bf16_t*)(c.ws + WS_WGLU);
        constexpr int I_IN = 16 * 192, I_A = 4 * 32, I_B = 8 * 32, I_C = 4 * 32, I_O = 16 * 32, I_G = 4 * 8;
        constexpr int NITEMS = I_IN + I_A + I_B + I_C + I_O + I_G;
        for (int it = gw; it < NITEMS; it += NGW) {
            int r = it;
            if (r < I_IN) { const int kb = r / 192, nb = r % 192; const float* src = c.inp(IN_WIN) + (size_t)l * 1024 * DIN + (nb >= 64 ? 8 : 0);
                transpose_item(src, DIN, Win_t, 1024, kb, nb, scr, lane); continue; } r -= I_IN;
            if (r < I_A) { transpose_item(c.inp(IN_WUPA) + (size_t)l * 256 * 1024, 1024, Wup_t, 1024, r / 32, r % 32, scr, lane); continue; } r -= I_A;
            if (r < I_B) { transpose_item(c.inp(IN_WUPB) + (size_t)l * 512 * 1024, 1024, Wup_t + 256, 1024, r / 32, r % 32, scr, lane); continue; } r -= I_B;
            if (r < I_C) { transpose_item(c.inp(IN_WUPC) + (size_t)l * 256 * 1024, 1024, Wup_t + 768, 1024, r / 32, r % 32, scr, lane); continue; } r -= I_C;
            if (r < I_O) { transpose_item(c.inp(IN_WOUT) + (size_t)l * 1024 * 1024, 1024, Wout_t, 1024, r / 32, r % 32, scr, lane); continue; } r -= I_O;
            transpose_item(c.inp(IN_WGLU) + (size_t)l * 256 * 256, 256, Wglu_t, 256, r / 8, r % 8, scr, lane);
        }
    }
    f32x4 wf[16][2];
    float bfv[8];
    if (l < NLAYER) {
        const float* wp = c.inp(IN_WIN) + (size_t)l * 1024 * DIN + 2048;
#pragma unroll
        for (int j = 0; j < 4; ++j)
#pragma unroll
            for (int i = 0; i < 4; ++i) { const float* q = wp + (size_t)(256 * j + 4 * lane + i) * DIN; wf[4 * j + i][0] = *(const f32x4*)q; wf[4 * j + i][1] = *(const f32x4*)(q + 4); }
#pragma unroll
        for (int h = 0; h < 8; ++h) bfv[h] = c.inp(IN_BIN)[(size_t)l * DIN + 2048 + h];
    }
    const float* src = (l == 0) ? c.inp(IN_X) : c.out;
    bf16_t* XB = (bf16_t*)(c.ws + WS_XB);
    float* flog = (float*)(c.ws + WS_FLOG);
    for (int m0 = gw; m0 < MTOK; m0 += 2 * NGW) {
        f32x4 v[2][4];
#pragma unroll
        for (int q = 0; q < 2; ++q) { const int mr = min(m0 + q * NGW, MTOK - 1); const f32x4* xr = (const f32x4*)(src + (size_t)mr * DM) + lane;
#pragma unroll
            for (int j = 0; j < 4; ++j) v[q][j] = xr[64 * j]; }
#pragma unroll
        for (int q = 0; q < 2; ++q) {
        const int m = m0 + q * NGW;
        if (m >= MTOK) continue;
        if (l > 0) {
            float s = 0.f;
#pragma unroll
            for (int j = 0; j < 4; ++j) s += (v[q][j].x + v[q][j].y) + (v[q][j].z + v[q][j].w);
            const float mean = wave_sum(s) * (1.f / DM); float s2 = 0.f;
#pragma unroll
            for (int j = 0; j < 4; ++j) { v[q][j] = v[q][j] - mean; s2 += (v[q][j].x * v[q][j].x + v[q][j].y * v[q][j].y) + (v[q][j].z * v[q][j].z + v[q][j].w * v[q][j].w); }
            const float rstd = 1.f / sqrtf(wave_sum(s2) * (1.f / DM) + LN_EPS);
            const f32x4* gp = (const f32x4*)(c.inp(IN_LNG) + (size_t)(l - 1) * DM) + lane; const f32x4* bp = (const f32x4*)(c.inp(IN_LNB) + (size_t)(l - 1) * DM) + lane;
            f32x4* orow = (f32x4*)(c.out + (size_t)m * DM) + lane;
#pragma unroll
            for (int j = 0; j < 4; ++j) { v[q][j] = v[q][j] * rstd * gp[64 * j] + bp[64 * j]; if (l == NLAYER) orow[64 * j] = v[q][j]; }
            if (l < NLAYER && lane == 0) *(float2*)((float*)(c.ws + WS_STATS) + (size_t)m * 2) = make_float2(mean, rstd);
        }
        if (l < NLAYER) {
            u32x2* o8 = (u32x2*)(XB + (size_t)m * DM) + lane;
#pragma unroll
            for (int j = 0; j < 4; ++j) { u32x2 w; w.x = pk_bf16(v[q][j].x, v[q][j].y); w.y = pk_bf16(v[q][j].z, v[q][j].w); o8[64 * j] = w; }
            f32x4 a0 = {0.f, 0.f, 0.f, 0.f}, a1 = {0.f, 0.f, 0.f, 0.f};
#pragma unroll
            for (int j = 0; j < 4; ++j)
#pragma unroll
                for (int i = 0; i < 4; ++i) { const float xv = v[q][j][i]; a0 += wf[4 * j + i][0] * xv; a1 += wf[4 * j + i][1] * xv; }
            float f[8];
#pragma unroll
            for (int h = 0; h < 4; ++h) { f[h] = wave_sum(a0[h]) + bfv[h]; f[4 + h] = wave_sum(a1[h]) + bfv[4 + h]; }
            if (lane == 0) { *(f32x4*)(flog + (size_t)m * 8) = (f32x4){f[0], f[1], f[2], f[3]}; *(f32x4*)(flog + (size_t)m * 8 + 4) = (f32x4){f[4], f[5], f[6], f[7]}; }
        }
        }
    }
}

__device__ __forceinline__ void fcum_unit(const Ctx& c, int bh) {
    const int b = bh >> 3, h = bh & 7, tid = c.tid;
    const float* flog = (const float*)(c.ws + WS_FLOG);
    float* fcum = (float*)(c.ws + WS_FCUM);
    double* wtot = (double*)(c.lds);
    double loc[8]; double run = 0.0;
#pragma unroll
    for (int i = 0; i < 8; ++i) { const float f = flog[((size_t)b * SEQ + 8 * tid + i) * 8 + h]; const float ls = fminf(f, 0.f) - log1pf(expf(-fabsf(f))); run += (double)ls; loc[i] = run; }
    double incl = run;
#pragma unroll
    for (int o = 1; o < 64; o <<= 1) { const double t = __shfl_up(incl, o); if (c.lane >= o) incl += t; }
    if (c.lane == 63) wtot[c.wave] = incl;
    __syncthreads();
    double base = incl - run;
    for (int w = 0; w < c.wave; ++w) base += wtot[w];
#pragma unroll
    for (int i = 0; i < 8; ++i) fcum[(size_t)bh * SEQ + 8 * tid + i] = (float)((base + loc[i]) * 1.4426950408889634);
    __syncthreads();
}

__device__ __forceinline__ void norm_unit(const Ctx& c, int l, int tile) {
    const int tid = c.tid, tok = tile * 128 + (tid >> 2), part = tid & 3, b = tile >> 5;
    const bf16_t* Q = (const bf16_t*)(c.ws + WS_Z + 1 * ZARR); const bf16_t* K = (const bf16_t*)(c.ws + WS_Z + 2 * ZARR);
    unsigned* nrm = (unsigned*)(c.ws + WS_NORM) + (size_t)l * 128;
    float res[4];
#pragma unroll
    for (int a = 0; a < 2; ++a)
#pragma unroll
        for (int hh = 0; hh < 2; ++hh) { const u32x4* p = (const u32x4*)((a == 0 ? Q : K) + (size_t)tok * 512 + (2 * part + hh) * 64);
            float s0 = 0.f, s1 = 0.f;
#pragma unroll
            for (int j = 0; j < 8; ++j) { const u32x4 w = p[j];
                s0 += bf_lo(w.x) * bf_lo(w.x) + bf_hi(w.x) * bf_hi(w.x) + bf_lo(w.y) * bf_lo(w.y) + bf_hi(w.y) * bf_hi(w.y);
                s1 += bf_lo(w.z) * bf_lo(w.z) + bf_hi(w.z) * bf_hi(w.z) + bf_lo(w.w) * bf_lo(w.w) + bf_hi(w.w) * bf_hi(w.w); }
            res[a * 2 + hh] = (s0 + s1) * 1.0001f + 1e-30f; }
#pragma unroll
    for (int i = 0; i < 4; ++i) { float v = res[i];
#pragma unroll
        for (int o = 4; o < 64; o <<= 1) v = fmaxf(v, __shfl_xor(v, o));
        res[i] = v; }
    if (c.lane < 4) {
#pragma unroll
        for (int a = 0; a < 2; ++a)
#pragma unroll
            for (int hh = 0; hh < 2; ++hh) atomicMax(nrm + (size_t)(b * 8 + 2 * part + hh) * 2 + a, __float_as_uint(res[a * 2 + hh]));
    }
}

__device__ __forceinline__ void pool_tile(const Ctx& c, int l, int tile) {
    const int tid = c.tid, lane = c.lane, wave = c.wave;
    const bf16_t* ZA = (const bf16_t*)(c.ws + WS_Z);
    bf16_t* Y = (bf16_t*)(c.ws + WS_XB);
    float* U = (float*)c.lds;
    float* Pm = (float*)(c.lds + 40960);
    const int t0 = tile * 128, pos0 = t0 & (SEQ - 1);
    u32x4 pre[3];
#define POOL_FETCH(gi_) do { _Pragma("unroll") for (int k_ = 0; k_ < 3; ++k_) { const int it_ = tid + 512 * k_; const int r_ = it_ >> 3, ch_ = it_ & 7; pre[k_] = (u32x4){0u, 0u, 0u, 0u}; \
        if (it_ < 143 * 8 && !(pos0 == 0 && r_ < 15)) pre[k_] = *(const u32x4*)(ZA + (size_t)(t0 - 15 + r_) * 512 + (gi_) * 64 + ch_ * 8); } } while (0)
    POOL_FETCH(0);
#pragma unroll 1
    for (int gi = 0; gi < 4; ++gi) {
        const int w = 2 << gi;
#pragma unroll
        for (int k = 0; k < 3; ++k) { const int it = tid + 512 * k; const int r = it >> 3, ch = it & 7;
            if (it < 143 * 8) { const u32x4 q = pre[k];
                *(f32x4*)(U + r * 64 + ch * 8) = (f32x4){bf_lo(q.x), bf_hi(q.x), bf_lo(q.y), bf_hi(q.y)}; *(f32x4*)(U + r * 64 + ch * 8 + 4) = (f32x4){bf_lo(q.z), bf_hi(q.z), bf_lo(q.w), bf_hi(q.w)}; } }
        __syncthreads();
        if (gi < 3) POOL_FETCH(gi + 1);
        {
            const int ch = tid & 63, i0 = (tid >> 6) * 16;
            float s = 0.f;
            for (int j = 1; j < w; ++j) s += U[(15 + i0 - j) * 64 + ch];
            for (int i = i0; i < i0 + 16; ++i) {
                const float cur = U[(15 + i) * 64 + ch]; s += cur;
                const int cnt = min(pos0 + i + 1, w);
                Pm[i * 65 + ch] = s / (float)cnt - cur;
                s -= U[(15 + i - (w - 1)) * 64 + ch];
            }
        }
        __syncthreads();
        {
            const int rt = wave >> 1, ct = wave & 1, li = lane & 31, lh = lane >> 5;
            const int j = 32 * ct + li;
            unsigned short gv[16];
#pragma unroll
            for (int r = 0; r < 16; ++r) { const int i = (r & 3) + 8 * (r >> 2) + 4 * lh; gv[r] = ZA[(size_t)(t0 + 32 * rt + i) * 512 + 256 + gi * 64 + j]; }
            const float* pw = c.inp(IN_POOLW) + (size_t)(l * 4 + gi) * 4096 + j;
            const float sc = c.inp(IN_POOLS)[l * 256 + gi * 64 + j];
            f32x16 acc = {};
#pragma unroll 8
            for (int s = 0; s < 32; ++s) {
                const float a = Pm[(32 * rt + li) * 65 + 2 * s + lh];
                const float b = pw[(size_t)(2 * s + lh) * 64];
                acc = __builtin_amdgcn_mfma_f32_32x32x2f32(a, b, acc, 0, 0, 0);
            }
#pragma unroll
            for (int r = 0; r < 16; ++r) {
                const int i = (r & 3) + 8 * (r >> 2) + 4 * lh; const size_t tok = (size_t)(t0 + 32 * rt + i);
                const float v = acc[r] * sc * __uint_as_float((unsigned)gv[r] << 16);
                Y[tok * 1024 + gi * 64 + j] = (bf16_t)(pk_bf16(v, 0.f) & 0xffffu);
            }
        }
        __syncthreads();
    }
#undef POOL_FETCH
}

__device__ __forceinline__ void ssm_setup(const Ctx& c, int l, int g, int p, float& ar, float& ai, float (&bbr)[16], float (&bbi)[16]) {
    const int gp = (l * 16 + g) * 64 + p;
    const float are = c.inp(IN_ARE)[gp], aim = c.inp(IN_AIM)[gp], dt = expf(c.inp(IN_LOGDT)[l * 16 + g]);
    const float mag = expf(are * dt), ang = aim * dt;
    ar = mag * cosf(ang); ai = mag * sinf(ang);
    const float den = are * are + aim * aim, nr = ar - 1.0f;
    const float cr = (nr * are + ai * aim) / den, ci = (ai * are - nr * aim) / den;
    const f32x4* br = (const f32x4*)(c.inp(IN_BRE) + (size_t)gp * 16); const f32x4* bi = (const f32x4*)(c.inp(IN_BIM) + (size_t)gp * 16);
#pragma unroll
    for (int q = 0; q < 4; ++q) { const f32x4 r4 = br[q], i4 = bi[q];
#pragma unroll
        for (int i = 0; i < 4; ++i) { bbr[4 * q + i] = cr * r4[i] - ci * i4[i]; bbi[4 * q + i] = cr * i4[i] + ci * r4[i]; } }
}
typedef float f32x2s __attribute__((ext_vector_type(2)));
#define SSM_STEP(up) do { const f32x4 u0_ = (up)[0], u1_ = (up)[1], u2_ = (up)[2], u3_ = (up)[3]; \
    f32x2s s0_ = bb2[0] * u0_[0], s1_ = bb2[4] * u1_[0], s2_ = bb2[8] * u2_[0], s3_ = bb2[12] * u3_[0]; \
    _Pragma("unroll") for (int i_ = 1; i_ < 4; ++i_) { s0_ += bb2[i_] * u0_[i_]; s1_ += bb2[4 + i_] * u1_[i_]; s2_ += bb2[8 + i_] * u2_[i_]; s3_ += bb2[12 + i_] * u3_[i_]; } \
    const f32x2s bu_ = (s0_ + s1_) + (s2_ + s3_); \
    const f32x2s nx_ = (f32x2s){xr, xi} * ar + (f32x2s){-xi, xr} * ai + bu_; xr = nx_[0]; xi = nx_[1]; } while (0)

__device__ __forceinline__ void ssm_store_u(float* Ul, const u32x4 q, int lane) {
    if (lane < 32) { float* d = Ul + (lane >> 1) * 16 + (lane & 1) * 8;
        *(f32x4*)d = (f32x4){bf_lo(q.x), bf_hi(q.x), bf_lo(q.y), bf_hi(q.y)}; *(f32x4*)(d + 4) = (f32x4){bf_lo(q.z), bf_hi(q.z), bf_lo(q.w), bf_hi(q.w)}; }
}
__device__ __forceinline__ void ssm_pass1(const Ctx& c, int l) {
    const int gw = c.vcu * 8 + c.wave, NGW = c.G * 8, lane = c.lane;
    const bf16_t* ZC = (const bf16_t*)(c.ws + WS_Z + 5 * ZARR);
    float* send = (float*)(c.ws + WS_SEND);
    float* Ul = (float*)(c.lds + 81920 + c.wave * 1024);
    for (int task = gw; task < 2048; task += NGW) {
        const int bg = task >> 4, tk = task & 15, b = bg >> 4, g = bg & 15;
        if (tk == 15) continue;
        float ar, ai, bbr[16], bbi[16]; ssm_setup(c, l, g, lane, ar, ai, bbr, bbi);
        f32x2s bb2[16];
#pragma unroll
        for (int h_ = 0; h_ < 16; ++h_) bb2[h_] = (f32x2s){bbr[h_], bbi[h_]};
        float xr = 0.f, xi = 0.f;
        const size_t row0 = (size_t)b * SEQ + tk * 256;
        const bf16_t* up = ZC + (row0 + (lane >> 1)) * 512 + g * 16 + (lane & 1) * 8;
        u32x4 q[4];
#pragma unroll
        for (int i = 0; i < 4; ++i) { q[i] = (u32x4){0u, 0u, 0u, 0u}; if (lane < 32) q[i] = *(const u32x4*)(up + (size_t)i * 16 * 512); }
#pragma unroll 1
        for (int sub4 = 0; sub4 < 16; sub4 += 4) {
#pragma unroll
            for (int si = 0; si < 4; ++si) {
                ssm_store_u(Ul, q[si], lane);
                if (sub4 + 4 < 16 && lane < 32) q[si] = *(const u32x4*)(up + (size_t)(sub4 + si + 4) * 16 * 512);
                LDS_FENCE();
#pragma unroll 4
                for (int tt = 0; tt < 16; ++tt) SSM_STEP((const f32x4*)(Ul + tt * 16));
                LDS_FENCE();
            }
        }
        *(float2*)(send + ((size_t)(bg * 16 + tk) * 64 + lane) * 2) = make_float2(xr, xi);
    }
}
__device__ __forceinline__ void ssm_pass2(const Ctx& c, int l) {
    const int gw = c.vcu * 8 + c.wave, NGW = c.G * 8, lane = c.lane;
    const bf16_t* ZC = (const bf16_t*)(c.ws + WS_Z + 5 * ZARR);
    bf16_t* YG = (bf16_t*)(c.ws + WS_Z);
    const float* send = (const float*)(c.ws + WS_SEND);
    float* Ul = (float*)(c.lds + 81920 + c.wave * 1024);
    float* Xl = (float*)(c.lds + c.wave * 8448);
    for (int task = gw; task < 2048; task += NGW) {
        const int bg = task >> 4, tk = task & 15, b = bg >> 4, g = bg & 15;
        float ar, ai, bbr[16], bbi[16]; ssm_setup(c, l, g, lane, ar, ai, bbr, bbi);
        f32x2s bb2[16];
#pragma unroll
        for (int h_ = 0; h_ < 16; ++h_) bb2[h_] = (f32x2s){bbr[h_], bbi[h_]};
        float Cm[32];
        { const int h = lane & 15, kq = lane >> 4; const size_t cb = ((size_t)(l * 16 + g) * 16 + h) * 64;
#pragma unroll
          for (int s = 0; s < 16; ++s) { Cm[s] = c.inp(IN_CRE)[cb + 4 * s + kq]; Cm[16 + s] = -c.inp(IN_CIM)[cb + 4 * s + kq]; } }
        const float dsk = c.inp(IN_DSKIP)[l * 256 + g * 16 + (lane & 15)];
        float xr = 0.f, xi = 0.f;
        if (tk > 0) {
            float pr = ar, pi = ai;
#pragma unroll
            for (int q = 0; q < 8; ++q) { const float nr = pr * pr - pi * pi, ni = 2.f * pr * pi; pr = nr; pi = ni; }
            for (int j = 0; j < tk; ++j) { const float2 e = *(const float2*)(send + ((size_t)(bg * 16 + j) * 64 + lane) * 2);
                const float nr = pr * xr - pi * xi + e.x, ni = pr * xi + pi * xr + e.y; xr = nr; xi = ni; }
        }
        const size_t row0 = (size_t)b * SEQ + tk * 256;
        const bf16_t* up = ZC + (row0 + (lane >> 1)) * 512 + g * 16 + (lane & 1) * 8;
        u32x4 q[4];
#pragma unroll
        for (int i = 0; i < 4; ++i) { q[i] = (u32x4){0u, 0u, 0u, 0u}; if (lane < 32) q[i] = *(const u32x4*)(up + (size_t)i * 16 * 512); }
#pragma unroll 1
        for (int sub4 = 0; sub4 < 16; sub4 += 4)
#pragma unroll
        for (int si = 0; si < 4; ++si) {
            const int sub = sub4 + si;
            ssm_store_u(Ul, q[si], lane);
            if (sub4 + 4 < 16 && lane < 32) q[si] = *(const u32x4*)(up + (size_t)(sub + 4) * 16 * 512);
            LDS_FENCE();
            {
                f32x4 un[4];
#pragma unroll
                for (int k = 0; k < 4; ++k) un[k] = ((const f32x4*)Ul)[k];
#pragma unroll
                for (int tt = 0; tt < 16; ++tt) {
                    const f32x4 uc[4] = {un[0], un[1], un[2], un[3]};
                    if (tt + 1 < 16) {
#pragma unroll
                        for (int k = 0; k < 4; ++k) un[k] = ((const f32x4*)(Ul + (tt + 1) * 16))[k]; }
                    SSM_STEP(uc);
                    Xl[tt * 129 + lane] = xr; Xl[tt * 129 + 64 + lane] = xi;
                }
            }
            LDS_FENCE();
            f32x4 a0 = {0.f, 0.f, 0.f, 0.f}, a1 = {0.f, 0.f, 0.f, 0.f};
            const float* xa = Xl + (lane & 15) * 129 + (lane >> 4);
#pragma unroll
            for (int s = 0; s < 32; s += 2) {
                a0 = __builtin_amdgcn_mfma_f32_16x16x4f32(xa[4 * s], Cm[s], a0, 0, 0, 0);
                a1 = __builtin_amdgcn_mfma_f32_16x16x4f32(xa[4 * s + 4], Cm[s + 1], a1, 0, 0, 0);
            }
            const int h = lane & 15;
#pragma unroll
            for (int i = 0; i < 4; ++i) { const int tt = 4 * (lane >> 4) + i;
                float y = a0[i] + a1[i] + dsk * Ul[tt * 16 + h];
                const float z = 0.7978845608028654f * (y + 0.044715f * y * y * y);
                y = y * sigm(2.0f * z);
                YG[(row0 + sub * 16 + tt) * 256 + g * 16 + h] = (bf16_t)(pk_bf16(y, 0.f) & 0xffffu); }
            LDS_FENCE();
        }
    }
}

__device__ __forceinline__ void ssm2_coef(const Ctx& c, int l, int g, int p, int hi, float& ar, float& ai, float (&br)[8], float (&bi)[8]) {
    const int gp = (l * 16 + g) * 64 + p;
    const float are = c.inp(IN_ARE)[gp], aim = c.inp(IN_AIM)[gp], dt = expf(c.inp(IN_LOGDT)[l * 16 + g]);
    const float mag = expf(are * dt), ang = aim * dt;
    ar = mag * cosf(ang); ai = mag * sinf(ang);
    const float den = are * are + aim * aim, nr = ar - 1.0f;
    const float cr = (nr * are + ai * aim) / den, ci = (ai * are - nr * aim) / den;
    const f32x4* pr = (const f32x4*)(c.inp(IN_BRE) + (size_t)gp * 16 + 8 * hi); const f32x4* pi = (const f32x4*)(c.inp(IN_BIM) + (size_t)gp * 16 + 8 * hi);
#pragma unroll
    for (int q4 = 0; q4 < 2; ++q4) { const f32x4 r4 = pr[q4], i4 = pi[q4];
#pragma unroll
        for (int i = 0; i < 4; ++i) { br[4 * q4 + i] = cr * r4[i] - ci * i4[i]; bi[4 * q4 + i] = cr * i4[i] + ci * r4[i]; } }
}
__device__ __forceinline__ void split_bf16x8(const float (&v)[8], bf16x8& hi8, bf16x8& lo8) {
    u32x4 hw, lw;
#pragma unroll
    for (int k = 0; k < 4; ++k) { const unsigned h = pk_bf16(v[2 * k], v[2 * k + 1]); const unsigned lo = pk_bf16(v[2 * k] - bf_lo(h), v[2 * k + 1] - bf_hi(h)); hw[k] = h; lw[k] = lo; }
    hi8 = __builtin_bit_cast(bf16x8, hw); lo8 = __builtin_bit_cast(bf16x8, lw);
}
__device__ __forceinline__ float half_bcast(float x, int which) {
    auto rr = __builtin_amdgcn_permlane32_swap(__float_as_uint(x), __float_as_uint(x), false, false);
    return __uint_as_float(which == 0 ? rr[0] : rr[1]);
}
template <bool PASS2> __device__ __forceinline__ void ssm2_pass(const Ctx& c, int l) {
    const int gw = c.vcu * 8 + c.wave, NGW = c.G * 8, lane = c.lane, q = lane & 31, hi = lane >> 5;
    const bf16_t* ZC = (const bf16_t*)(c.ws + WS_Z + 5 * ZARR);
    bf16_t* YG = (bf16_t*)(c.ws + WS_Z);
    float* send = (float*)(c.ws + WS_SEND);
    float* Ul = (float*)(c.lds + 81920 + c.wave * 2048);
    unsigned* XP = (unsigned*)(c.lds + c.wave * 8448);
    for (int task = gw; task < 2048; task += NGW) {
        const int bg = task >> 4, tk = task & 15, b = bg >> 4, g = bg & 15;
        if (!PASS2 && tk == 15) continue;
        float arA, aiA, arB, aiB; bf16x8 Bh[4], Bl[4];
        { float t0[8], t1[8];
          ssm2_coef(c, l, g, q, hi, arA, aiA, t0, t1); split_bf16x8(t0, Bh[0], Bl[0]); split_bf16x8(t1, Bh[2], Bl[2]);
          ssm2_coef(c, l, g, 32 + q, hi, arB, aiB, t0, t1); split_bf16x8(t0, Bh[1], Bl[1]); split_bf16x8(t1, Bh[3], Bl[3]); }
        bf16x8 Cb[8]; float dsk = 0.f;
        if (PASS2) { const int h = lane & 15, kq = 4 * (lane >> 4); const size_t cb = ((size_t)(l * 16 + g) * 16 + h) * 64;
#pragma unroll
            for (int s_ = 0; s_ < 8; ++s_) { const float* src = (s_ < 4 ? c.inp(IN_CRE) : c.inp(IN_CIM)) + cb + 16 * (s_ & 3) + kq; const float sg = (s_ < 4) ? 1.f : -1.f;
                const f32x4 v0 = *(const f32x4*)src;
                const u32x4 w = {pk_bf16(sg * v0[0], sg * v0[0]), pk_bf16(sg * v0[1], sg * v0[1]), pk_bf16(sg * v0[2], sg * v0[2]), pk_bf16(sg * v0[3], sg * v0[3])};
                Cb[s_] = __builtin_bit_cast(bf16x8, w); }
            dsk = c.inp(IN_DSKIP)[l * 256 + g * 16 + h]; }
        float xAr = 0.f, xAi = 0.f, xBr = 0.f, xBi = 0.f;
        if (PASS2 && tk > 0) {
            float pAr = arA, pAi = aiA, pBr = arB, pBi = aiB;
#pragma unroll
            for (int k = 0; k < 8; ++k) { float nr = pAr * pAr - pAi * pAi, ni = 2.f * pAr * pAi; pAr = nr; pAi = ni; nr = pBr * pBr - pBi * pBi; ni = 2.f * pBr * pBi; pBr = nr; pBi = ni; }
            for (int j = 0; j < tk; ++j) { const float2 eA = *(const float2*)(send + ((size_t)(bg * 16 + j) * 64 + q) * 2), eB = *(const float2*)(send + ((size_t)(bg * 16 + j) * 64 + 32 + q) * 2);
                float nr = pAr * xAr - pAi * xAi + eA.x, ni = pAr * xAi + pAi * xAr + eA.y; xAr = nr; xAi = ni;
                nr = pBr * xBr - pBi * xBi + eB.x; ni = pBr * xBi + pBi * xBr + eB.y; xBr = nr; xBi = ni; }
        }
        const size_t row0 = (size_t)b * SEQ + tk * 256;
        const bf16_t* up = ZC + (row0 + q) * 512 + g * 16 + 8 * hi;
        bf16x8 an = *(const bf16x8*)up;
#pragma unroll 1
        for (int blk = 0; blk < 8; ++blk) {
            const bf16x8 a = an;
            if (blk + 1 < 8) an = *(const bf16x8*)(up + (size_t)(blk + 1) * 32 * 512);
            if (PASS2) { const u32x4 w = __builtin_bit_cast(u32x4, a); float* d = Ul + q * 16 + 8 * hi;
                *(f32x4*)d = (f32x4){bf_lo(w.x), bf_hi(w.x), bf_lo(w.y), bf_hi(w.y)}; *(f32x4*)(d + 4) = (f32x4){bf_lo(w.z), bf_hi(w.z), bf_lo(w.w), bf_hi(w.w)}; }
            f32x16 D0 = {}, D1 = {}, D2 = {}, D3 = {};
            D0 = __builtin_amdgcn_mfma_f32_32x32x16_bf16(a, Bh[0], D0, 0, 0, 0); D1 = __builtin_amdgcn_mfma_f32_32x32x16_bf16(a, Bh[1], D1, 0, 0, 0);
            D2 = __builtin_amdgcn_mfma_f32_32x32x16_bf16(a, Bh[2], D2, 0, 0, 0); D3 = __builtin_amdgcn_mfma_f32_32x32x16_bf16(a, Bh[3], D3, 0, 0, 0);
            D0 = __builtin_amdgcn_mfma_f32_32x32x16_bf16(a, Bl[0], D0, 0, 0, 0); D1 = __builtin_amdgcn_mfma_f32_32x32x16_bf16(a, Bl[1], D1, 0, 0, 0);
            D2 = __builtin_amdgcn_mfma_f32_32x32x16_bf16(a, Bl[2], D2, 0, 0, 0); D3 = __builtin_amdgcn_mfma_f32_32x32x16_bf16(a, Bl[3], D3, 0, 0, 0);
#pragma unroll
            for (int gq = 0; gq < 4; ++gq) {
#pragma unroll
                for (int ps = 0; ps < 2; ++ps) {
#pragma unroll
                    for (int i = 0; i < 4; ++i) { const int r = 4 * gq + i;
                        float nr = arA * xAr - aiA * xAi + D0[r], ni = arA * xAi + aiA * xAr + D2[r]; xAr = nr; xAi = ni;
                        nr = arB * xBr - aiB * xBi + D1[r]; ni = arB * xBi + aiB * xBr + D3[r]; xBr = nr; xBi = ni;
                        if (PASS2) { if (hi == ps) { const int row = (8 * gq + 4 * ps + i) & 15;
                            const unsigned hr = pk_bf16(xAr, xBr), hm = pk_bf16(xAi, xBi);
                            const unsigned lr = pk_bf16(xAr - bf_lo(hr), xBr - bf_hi(hr)), lm = pk_bf16(xAi - bf_lo(hm), xBi - bf_hi(hm));
                            XP[row * 132 + q] = (hr & 0xffffu) | (lr << 16); XP[row * 132 + 32 + q] = (hr >> 16) | (lr & 0xffff0000u);
                            XP[row * 132 + 64 + q] = (hm & 0xffffu) | (lm << 16); XP[row * 132 + 96 + q] = (hm >> 16) | (lm & 0xffff0000u); } } }
                    xAr = half_bcast(xAr, ps); xAi = half_bcast(xAi, ps); xBr = half_bcast(xBr, ps); xBi = half_bcast(xBi, ps);
                }
                if (PASS2 && (gq & 1)) {
                    LDS_FENCE();
                    f32x4 a0 = {0.f, 0.f, 0.f, 0.f}, a1 = {0.f, 0.f, 0.f, 0.f};
                    const unsigned* xp = XP + (lane & 15) * 132 + 4 * (lane >> 4);
#pragma unroll
                    for (int s_ = 0; s_ < 8; s_ += 2) {
                        a0 = __builtin_amdgcn_mfma_f32_16x16x32_bf16(*(const bf16x8*)(xp + 16 * s_), Cb[s_], a0, 0, 0, 0);
                        a1 = __builtin_amdgcn_mfma_f32_16x16x32_bf16(*(const bf16x8*)(xp + 16 * s_ + 16), Cb[s_ + 1], a1, 0, 0, 0);
                    }
                    const int h = lane & 15, t16 = (gq >> 1) * 16;
#pragma unroll
                    for (int i = 0; i < 4; ++i) { const int tt = 4 * (lane >> 4) + i;
                        float y = a0[i] + a1[i] + dsk * Ul[(t16 + tt) * 16 + h];
                        const float z = 0.7978845608028654f * (y + 0.044715f * y * y * y);
                        y = y * sigm(2.0f * z);
                        YG[(row0 + blk * 32 + t16 + tt) * 256 + g * 16 + h] = (bf16_t)(pk_bf16(y, 0.f) & 0xffffu); }
                    LDS_FENCE();
                }
            }
        }
        if (!PASS2) { if (hi == 0) { *(float2*)(send + ((size_t)(bg * 16 + tk) * 64 + q) * 2) = make_float2(xAr, xAi); *(float2*)(send + ((size_t)(bg * 16 + tk) * 64 + 32 + q) * 2) = make_float2(xBr, xBi); } }
    }
}

namespace fox {
constexpr int D = 64, PITCH = 512, NW = 8, QBLK = 32, QB = 256, KVBLK = 64;
constexpr int SLOTB = 8192;
constexpr int NSLOT = 4;
constexpr int L_K = 0, L_V = NSLOT * SLOTB, L_WS = 2 * NSLOT * SLOTB, L_OST = L_WS + NW * 64 * 4, L_F = L_OST + NW * 4096, L_END = L_F + SEQ * 4;
__device__ __forceinline__ int crow(int r, int hi) { return (r & 3) + 8 * (r >> 2) + 4 * hi; }
__device__ __forceinline__ void glds16(const void* gsrc, unsigned lds_dst) { unsigned keep;
    asm volatile("s_mov_b32 %0, m0\n\ts_mov_b32 m0, %2\n\ts_nop 0\n\tglobal_load_lds_dwordx4 %1, off\n\ts_mov_b32 m0, %0" : "=&s"(keep) : "v"(gsrc), "s"(lds_dst) : "memory"); }
typedef __attribute__((address_space(3))) const char* lds_cptr;
typedef short v4i16_t __attribute__((ext_vector_type(4)));
__device__ __forceinline__ s16x4 vtr(lds_cptr p) { return __builtin_bit_cast(s16x4, __builtin_amdgcn_ds_read_tr16_b64_v4i16((__attribute__((address_space(3))) v4i16_t*)p)); }
#define FOX_WAIT_BAR(N) asm volatile("s_waitcnt vmcnt(" #N ") lgkmcnt(0)\n\ts_barrier" ::: "memory")

__device__ __forceinline__ void attn_unit(const Ctx& c, int b, int h, int qb) {
    const int tid = c.tid, lane = c.lane, r32 = lane & 31, hi = lane >> 5, wid = c.wave;
    const bf16_t* Q = (const bf16_t*)(c.ws + WS_Z + 1 * ZARR); const bf16_t* K = (const bf16_t*)(c.ws + WS_Z + 2 * ZARR); const bf16_t* V = (const bf16_t*)(c.ws + WS_Z + 3 * ZARR);
    const bf16_t* GB = (const bf16_t*)(c.ws + WS_Z + 4 * ZARR); bf16_t* Y = (bf16_t*)(c.ws + WS_XB);
    const float* Fbh = (const float*)(c.ws + WS_FCUM) + (size_t)(b * NHEAD + h) * SEQ;
    char* shm = (char*)c.lds;
    const long rowbase = (long)b * SEQ; const int q0 = qb * QB;
    const bf16_t* Qw = Q + (rowbase + q0 + wid * QBLK) * PITCH + h * D;
    const bf16_t* Kh = K + rowbase * PITCH + h * D; const bf16_t* Vh = V + rowbase * PITCH + h * D;
    const unsigned lds0 = (unsigned)(uintptr_t)shm;
    float* wsf = (float*)(shm + L_WS) + wid * 64;
    float* Fl = (float*)(shm + L_F);
    const bf16_t* ksrc = Kh + (long)lane * PITCH + wid * 8;
    const bf16_t* vsrc = Vh + (long)(16 * (wid & 3) + (lane >> 2)) * PITCH + (wid >> 2) * 32 + (lane & 3) * 8;
    const unsigned kdst = lds0 + L_K + wid * 1024, vdst = lds0 + L_V + wid * 1024;
#define DMA_K(t, slot) glds16(ksrc + (long)(t) * KVBLK * PITCH, (unsigned)__builtin_amdgcn_readfirstlane(kdst + (slot)))
#define DMA_V(t, slot) glds16(vsrc + (long)(t) * KVBLK * PITCH, (unsigned)__builtin_amdgcn_readfirstlane(vdst + (slot)))
    const lds_cptr shm3 = (lds_cptr)(__attribute__((address_space(3))) const char*)(__attribute__((address_space(3))) unsigned char*)(uintptr_t)lds0;
    const lds_cptr vp0 = shm3 + L_V + ((lane >> 4) & 1) * 32 + (lane & 3) * 8 + (4 * hi + ((lane & 15) >> 2)) * 64;
    const int NT = (q0 + QB) / KVBLK;
    for (int i = tid; i < (q0 + QB) / 4; i += 512) *(f32x4*)(Fl + 4 * i) = *(const f32x4*)(Fbh + 4 * i);
    const float fq = Fbh[q0 + wid * QBLK + r32];
    bf16x8 qr[4];
#pragma unroll
    for (int d0 = 0; d0 < 4; ++d0) qr[d0] = *reinterpret_cast<const bf16x8*>(&Qw[(long)r32 * PITCH + d0 * 16 + hi * 8]);
    DMA_K(0, 0); DMA_V(0, 0); DMA_K(1, SLOTB); DMA_V(1, SLOTB); DMA_K(2, 2 * SLOTB); DMA_V(2, 2 * SLOTB);
    float mhat = -1e30f, l_reg = 0.f; f32x16 o[2]; o[0] = f32x16{}; o[1] = f32x16{};
    const int qrel = wid * QBLK + r32;
    for (int t = 0; t < NT; ++t) {
        const int cur = (t & 3) * SLOTB;
        if (t + 2 < NT) { FOX_WAIT_BAR(4); } else if (t + 1 < NT) { FOX_WAIT_BAR(2); } else { FOX_WAIT_BAR(0); }
        if (t + 3 < NT) { const int nxs = ((t + 3) & 3) * SLOTB; DMA_K(t + 3, nxs); DMA_V(t + 3, nxs); }
        const int jb = t - (NT - 4);
        if (!(jb > 0 && 64 * jb > wid * QBLK + 31)) {
            f32x16 p0, p1;
            { const float* fk = Fl + t * 64 + 4 * hi;
#pragma unroll
              for (int g = 0; g < 4; ++g) { const f32x4 a = *(const f32x4*)(fk + 8 * g), bb = *(const f32x4*)(fk + 32 + 8 * g);
#pragma unroll
                for (int i = 0; i < 4; ++i) { p0[4 * g + i] = fq - a[i]; p1[4 * g + i] = fq - bb[i]; } } }
            { const char* kb = shm + L_K + cur + hi * 1024 + r32 * 16;
#pragma unroll
              for (int d0 = 0; d0 < 4; ++d0) {
                const bf16x8 b0 = *reinterpret_cast<const bf16x8*>(kb + d0 * 2048);
                const bf16x8 b1 = *reinterpret_cast<const bf16x8*>(kb + d0 * 2048 + 512);
                p0 = __builtin_amdgcn_mfma_f32_32x32x16_bf16(b0, qr[d0], p0, 0, 0, 0);
                p1 = __builtin_amdgcn_mfma_f32_32x32x16_bf16(b1, qr[d0], p1, 0, 0, 0); } }
            if (jb >= 0) { const int kbase = 64 * jb + 4 * hi;
#pragma unroll
                for (int r = 0; r < 16; ++r) { const int kv = kbase + (r & 3) + 8 * (r >> 2); if (kv > qrel) p0[r] = -INFINITY; if (kv + 32 > qrel) p1[r] = -INFINITY; } }
            float rm;
            { float m0 = fmaxf(p0[0], p0[1]), m1 = fmaxf(p0[2], p0[3]), m2 = fmaxf(p1[0], p1[1]), m3 = fmaxf(p1[2], p1[3]);
#pragma unroll
              for (int r = 4; r < 16; r += 4) { m0 = fmaxf(fmaxf(m0, p0[r]), p0[r + 1]); m1 = fmaxf(fmaxf(m1, p0[r + 2]), p0[r + 3]); m2 = fmaxf(fmaxf(m2, p1[r]), p1[r + 1]); m3 = fmaxf(fmaxf(m3, p1[r + 2]), p1[r + 3]); }
              rm = fmaxf(fmaxf(m0, m1), fmaxf(m2, m3)); }
            { auto rr = __builtin_amdgcn_permlane32_swap(__float_as_uint(rm), __float_as_uint(rm), false, false); rm = fmaxf(__uint_as_float(rr[0]), __uint_as_float(rr[1])); }
            const float mnew = fmaxf(mhat, rm);
            const float f = __builtin_amdgcn_exp2f(mhat - mnew);
            mhat = mnew;
            float sacc;
            { float s0 = 0.f, s1 = 0.f, s2 = 0.f, s3 = 0.f;
#pragma unroll
              for (int r = 0; r < 16; r += 2) { p0[r] = __builtin_amdgcn_exp2f(p0[r] - mhat); p1[r] = __builtin_amdgcn_exp2f(p1[r] - mhat); p0[r + 1] = __builtin_amdgcn_exp2f(p0[r + 1] - mhat); p1[r + 1] = __builtin_amdgcn_exp2f(p1[r + 1] - mhat);
                  s0 += p0[r]; s1 += p1[r]; s2 += p0[r + 1]; s3 += p1[r + 1]; }
              sacc = (s0 + s1) + (s2 + s3); }
            l_reg = l_reg * f + sacc;
            if (__any(f != 1.0f)) {
                if (hi == 0) wsf[r32] = f;
                LDS_FENCE();
#pragma unroll
                for (int g = 0; g < 4; ++g) { const f32x4 fv = *(const f32x4*)(wsf + 8 * g + 4 * hi);
#pragma unroll
                    for (int i = 0; i < 4; ++i) { o[0][4 * g + i] *= fv[i]; o[1][4 * g + i] *= fv[i]; } }
                LDS_FENCE();
            }
            u32x4 pw0, pw1, pw2, pw3;
            pw0 = (u32x4){pk_bf16(p0[0], p0[1]), pk_bf16(p0[2], p0[3]), pk_bf16(p0[4], p0[5]), pk_bf16(p0[6], p0[7])};
            pw1 = (u32x4){pk_bf16(p0[8], p0[9]), pk_bf16(p0[10], p0[11]), pk_bf16(p0[12], p0[13]), pk_bf16(p0[14], p0[15])};
            pw2 = (u32x4){pk_bf16(p1[0], p1[1]), pk_bf16(p1[2], p1[3]), pk_bf16(p1[4], p1[5]), pk_bf16(p1[6], p1[7])};
            pw3 = (u32x4){pk_bf16(p1[8], p1[9]), pk_bf16(p1[10], p1[11]), pk_bf16(p1[12], p1[13]), pk_bf16(p1[14], p1[15])};
            const bf16x8 pa[4] = {__builtin_bit_cast(bf16x8, pw0), __builtin_bit_cast(bf16x8, pw1), __builtin_bit_cast(bf16x8, pw2), __builtin_bit_cast(bf16x8, pw3)};
            const lds_cptr vp = vp0 + cur;
#pragma unroll
            for (int ks = 0; ks < 4; ++ks)
#pragma unroll
                for (int d0 = 0; d0 < 2; ++d0) {
                    const s16x4 lo = vtr(vp + d0 * 4096 + ks * 1024), hh = vtr(vp + d0 * 4096 + ks * 1024 + 512);
                    const bf16x8 vf = (bf16x8){lo[0], lo[1], lo[2], lo[3], hh[0], hh[1], hh[2], hh[3]};
                    o[d0] = __builtin_amdgcn_mfma_f32_32x32x16_bf16(pa[ks], vf, o[d0], 0, 0, 0);
                }
        }
    }
    { auto rr = __builtin_amdgcn_permlane32_swap(__float_as_uint(l_reg), __float_as_uint(l_reg), false, false); l_reg = __uint_as_float(rr[0]) + __uint_as_float(rr[1]); }
    if (hi == 0) wsf[32 + r32] = l_reg;
    LDS_FENCE();
    float rli[16];
#pragma unroll
    for (int r = 0; r < 16; ++r) rli[r] = __builtin_amdgcn_rcpf(wsf[32 + crow(r, hi)]);
    {
        bf16_t* stg = (bf16_t*)(shm + L_OST) + wid * 2048;
#pragma unroll
        for (int r = 0; r < 16; ++r) { const int orow = crow(r, hi);
#pragma unroll
            for (int d0 = 0; d0 < 2; ++d0) stg[orow * 64 + d0 * 32 + r32] = (bf16_t)(pk_bf16(o[d0][r] * rli[r], 0.f) & 0xffffu); }
        LDS_FENCE();
        const long grow0 = rowbase + q0 + wid * QBLK;
#pragma unroll
        for (int i = 0; i < 4; ++i) { const int row = i * 8 + (lane >> 3), ch = lane & 7;
            const u32x4 v = *(const u32x4*)(stg + row * 64 + ch * 8);
            const u32x4 g = *(const u32x4*)(GB + (grow0 + row) * PITCH + h * D + ch * 8);
            u32x4 w;
            w.x = pk_bf16(bf_lo(v.x) * bf_lo(g.x), bf_hi(v.x) * bf_hi(g.x)); w.y = pk_bf16(bf_lo(v.y) * bf_lo(g.y), bf_hi(v.y) * bf_hi(g.y));
            w.z = pk_bf16(bf_lo(v.z) * bf_lo(g.z), bf_hi(v.z) * bf_hi(g.z)); w.w = pk_bf16(bf_lo(v.w) * bf_lo(g.w), bf_hi(v.w) * bf_hi(g.w));
            *(u32x4*)(Y + (grow0 + row) * 1024 + 256 + h * D + ch * 8) = w; }
    }
    asm volatile("s_waitcnt lgkmcnt(0)\n\ts_barrier" ::: "memory");
#undef DMA_K
#undef DMA_V
}
__device__ __forceinline__ void attn_phase(const Ctx& c) {
    for (int v = c.vcu; v < 256; v += c.G) {
        const int bh = v >> 2, j = v & 3;
#pragma unroll 1
        for (int i = 0; i < 4; ++i) { const int qb = (i == 0) ? j : (i == 1) ? 7 - j : (i == 2) ? 8 + j : 15 - j; attn_unit(c, bh >> 3, bh & 7, qb); }
    }
}
}


namespace fox2 {
using bf16=__hip_bfloat16;
using bf16x8=__attribute__((ext_vector_type(8)))short;
using s16x4=__attribute__((ext_vector_type(4)))short;
using f32x16=__attribute__((ext_vector_type(16)))float;
using u32x4=__attribute__((ext_vector_type(4)))unsigned;
typedef float f32x4v __attribute__((ext_vector_type(4)));
constexpr int D=64,PITCH=512;
constexpr int NW=8,QBLK=32,QB=QBLK*NW,KVBLK=64;
#define SBAR() __builtin_amdgcn_sched_barrier(0)
__device__ __forceinline__ int crow(int r,int hi){return (r&3)+8*(r>>2)+4*hi;}
#define SBAR() __builtin_amdgcn_sched_barrier(0)
__device__ __forceinline__ void cmask(f32x16&p0,f32x16&p1,int jb,int qrel,int hi){
  const float NEG=-INFINITY; int kb=64*jb+4*hi;
  #pragma unroll
  for(int r=0;r<16;++r){int kv=kb+(r&3)+8*(r>>2); if(kv>qrel)p0[r]=NEG; if(kv+32>qrel)p1[r]=NEG;}
}

constexpr int NSLOT=3, SLOTB=8192;
constexpr int LDS_K=0, LDS_V=NSLOT*SLOTB, LDS_WS=2*NSLOT*SLOTB, LDS_OST=LDS_WS+NW*64*4, LDS_F=LDS_OST+NW*4096, LDS_G=LDS_F+SEQ*4, LDS_BYTES=LDS_G+NW*4096;
constexpr float C2=0.125f*1.4426950408889634f;
__device__ __forceinline__ void glds16(const void*gsrc,unsigned lds_dst){unsigned keep;
  asm volatile("s_mov_b32 %0, m0\n\ts_mov_b32 m0, %2\n\ts_nop 0\n\tglobal_load_lds_dwordx4 %1, off\n\ts_mov_b32 m0, %0":"=&s"(keep):"v"(gsrc),"s"(lds_dst):"memory");}
__device__ __forceinline__ float max3f(float a,float b,float c){float r;asm("v_max3_f32 %0, %1, %2, %3":"=v"(r):"v"(a),"v"(b),"v"(c));return r;}
__device__ __forceinline__ float max2f(float a,float b){float r;asm("v_max_f32_e32 %0, %1, %2":"=v"(r):"v"(a),"v"(b));return r;}
__device__ __forceinline__ float fadd_s(float a,float b){float r;asm("v_add_f32_e32 %0, %1, %2":"=v"(r):"v"(a),"v"(b));return r;}
__device__ __forceinline__ float fsub_s(float a,float b){float r;asm("v_sub_f32_e32 %0, %1, %2":"=v"(r):"v"(a),"v"(b));return r;}
typedef float f32x2_t __attribute__((ext_vector_type(2))); typedef __bf16 bf16x2_t __attribute__((ext_vector_type(2)));
__device__ __forceinline__ unsigned cvtpk_s(float lo,float hi){f32x2_t v={lo,hi};bf16x2_t b=__builtin_convertvector(v,bf16x2_t);return __builtin_bit_cast(unsigned,b);}
#define WAIT_BAR(N) asm volatile("s_waitcnt vmcnt(" #N ") lgkmcnt(0)\n\ts_barrier":::"memory")

__device__ __forceinline__ void qkt(f32x16&p0,f32x16&p1,const char*Kslot,const bf16x8*qr,int r32,int hi){
  const char*kb=Kslot+hi*1024+r32*16;
  #pragma unroll
  for(int d0=0;d0<4;++d0){
    const bf16x8 b0=*reinterpret_cast<const bf16x8*>(kb+d0*2048);
    const bf16x8 b1=*reinterpret_cast<const bf16x8*>(kb+d0*2048+512);
    p0=__builtin_amdgcn_mfma_f32_32x32x16_bf16(b0,qr[d0],p0,0,0,0);p1=__builtin_amdgcn_mfma_f32_32x32x16_bf16(b1,qr[d0],p1,0,0,0);}
}
typedef __attribute__((address_space(3))) const char* lds_cptr;
typedef short v4i16_t __attribute__((ext_vector_type(4)));
__device__ __forceinline__ void kload8(bf16x8*kf,lds_cptr kp){
  kf[0]=*(const __attribute__((address_space(3))) bf16x8*)(kp);      kf[1]=*(const __attribute__((address_space(3))) bf16x8*)(kp+512);
  kf[2]=*(const __attribute__((address_space(3))) bf16x8*)(kp+2048); kf[3]=*(const __attribute__((address_space(3))) bf16x8*)(kp+2560);
  kf[4]=*(const __attribute__((address_space(3))) bf16x8*)(kp+4096); kf[5]=*(const __attribute__((address_space(3))) bf16x8*)(kp+4608);
  kf[6]=*(const __attribute__((address_space(3))) bf16x8*)(kp+6144); kf[7]=*(const __attribute__((address_space(3))) bf16x8*)(kp+6656);
}
__device__ __forceinline__ void kload2(bf16x8*kf,lds_cptr kp,int j){ kf[2*j]=*(const __attribute__((address_space(3))) bf16x8*)(kp+j*2048); kf[2*j+1]=*(const __attribute__((address_space(3))) bf16x8*)(kp+j*2048+512); }
__device__ __forceinline__ s16x4 vtr(lds_cptr p){ return __builtin_bit_cast(s16x4,__builtin_amdgcn_ds_read_tr16_b64_v4i16((__attribute__((address_space(3))) v4i16_t*)p)); }
__device__ __forceinline__ float rowmax(const f32x16&p0,const f32x16&p1){
  float a=max3f(p0[0],p0[1],p1[0]),b=max3f(p0[2],p0[3],p1[1]);a=max3f(a,p1[2],p1[3]);
  #pragma unroll
  for(int r=4;r<16;r+=4){a=max3f(a,p0[r],p0[r+1]);b=max3f(b,p0[r+2],p0[r+3]);a=max3f(a,p1[r],p1[r+1]);b=max3f(b,p1[r+2],p1[r+3]);}
  const float m=max2f(a,b);
  auto rr=__builtin_amdgcn_permlane32_swap(__float_as_uint(m),__float_as_uint(m),false,false);
  return max2f(__uint_as_float(rr[0]),__uint_as_float(rr[1]));
}
__device__ __forceinline__ void pv(f32x16*o,int vb,bf16x8 pa0,bf16x8 pa1,bf16x8 pa2,bf16x8 pa3){
  #pragma unroll
  for(int d0=0;d0<2;++d0){s16x4 lo[4],hi[4];
    #pragma unroll
    for(int ks=0;ks<4;++ks){
      asm volatile("ds_read_b64_tr_b16 %0,%1 offset:%c2":"=&v"(lo[ks]):"v"(vb),"i"(d0*4096+ks*1024):"memory");
      asm volatile("ds_read_b64_tr_b16 %0,%1 offset:%c2":"=&v"(hi[ks]):"v"(vb),"i"(d0*4096+ks*1024+512):"memory");}
    asm volatile("s_waitcnt lgkmcnt(0)":::"memory");SBAR();
    #define PK(k) (bf16x8){lo[k][0],lo[k][1],lo[k][2],lo[k][3],hi[k][0],hi[k][1],hi[k][2],hi[k][3]}
    o[d0]=__builtin_amdgcn_mfma_f32_32x32x16_bf16(pa0,PK(0),o[d0],0,0,0);
    o[d0]=__builtin_amdgcn_mfma_f32_32x32x16_bf16(pa1,PK(1),o[d0],0,0,0);
    o[d0]=__builtin_amdgcn_mfma_f32_32x32x16_bf16(pa2,PK(2),o[d0],0,0,0);
    o[d0]=__builtin_amdgcn_mfma_f32_32x32x16_bf16(pa3,PK(3),o[d0],0,0,0);
    #undef PK
  }
}

#ifndef ATTN_STORE16
#define ATTN_STORE16(p,v) (*(u32x4*)(p)=(v))
#endif
template<int THRL> __device__ __forceinline__ void attn_unit(int b,int h,int qb,const bf16*Q,const bf16*__restrict__ K,const bf16*__restrict__ V,const unsigned short*GB,unsigned short*Y,const float*Fcum,int ts,char*shm){
  int tid_=threadIdx.x; asm volatile("":"+v"(tid_));
  const int tid=tid_,lane=tid&63,r32=lane&31,hi=lane>>5; const int wid=__builtin_amdgcn_readfirstlane(tid>>6);
  const long rowbase=(long)b*SEQ; const int q0=qb*QB;
  const bf16*Qw=Q+(rowbase+q0+wid*QBLK)*PITCH+h*D;
  const float*Fbh=Fcum+(long)(b*NHEAD+h)*SEQ; float*Fl=(float*)(shm+LDS_F);
  const bf16*Kh=K+(rowbase+(long)ts*KVBLK)*PITCH+h*D,*Vh=V+(rowbase+(long)ts*KVBLK)*PITCH+h*D;
  const unsigned lds0=(unsigned)(uintptr_t)shm;
  float*wsf=(float*)(shm+LDS_WS)+wid*64;
  const bf16*ksrc=Kh+(long)lane*PITCH+wid*8;
  const bf16*vsrc=Vh+(long)(16*(wid&3)+(lane>>2))*PITCH+(wid>>2)*32+(lane&3)*8;
  const unsigned kdst=lds0+LDS_K+wid*1024, vdst=lds0+LDS_V+wid*1024;
  #define DMA_K(t,slot) glds16(ksrc+(long)(t)*KVBLK*PITCH,(unsigned)__builtin_amdgcn_readfirstlane(kdst+(slot)))
  #define DMA_V(t,slot) glds16(vsrc+(long)(t)*KVBLK*PITCH,(unsigned)__builtin_amdgcn_readfirstlane(vdst+(slot)))
  const int vb0=(int)(lds0+LDS_V)+((lane>>4)&1)*32+(lane&3)*8+(4*hi+((lane&15)>>2))*64;
  const char*Kbase=shm+LDS_K; bf16x8 kf[8];
  const lds_cptr shm3=(lds_cptr)shm; const lds_cptr kp0=shm3+LDS_K+hi*1024+r32*16; const lds_cptr vp0=shm3+LDS_V+((lane>>4)&1)*32+(lane&3)*8+(4*hi+((lane&15)>>2))*64;
  const int NT=(q0+QB)/KVBLK-ts;
  { const int np=(NT+3)>>2;
    if(wid<np)glds16((const char*)(Fbh+64*ts)+wid*1024+lane*16,(unsigned)__builtin_amdgcn_readfirstlane(lds0+LDS_F+wid*1024));
    if(wid+8<np)glds16((const char*)(Fbh+64*ts)+(wid+8)*1024+lane*16,(unsigned)__builtin_amdgcn_readfirstlane(lds0+LDS_F+(wid+8)*1024));
    const unsigned short*gsrc=GB+(rowbase+q0+wid*QBLK+(lane>>3))*PITCH+h*D+(lane&7)*8;
    #pragma unroll
    for(int i=0;i<4;++i)glds16(gsrc+(long)i*8*PITCH,(unsigned)__builtin_amdgcn_readfirstlane(lds0+LDS_G+wid*4096+i*1024)); }
  float nb=Fbh[q0+wid*QBLK+r32];
  DMA_K(0,0);DMA_V(0,0);DMA_K(1,SLOTB);
  bf16x8 qr[4];
  #pragma unroll
  for(int d0=0;d0<4;++d0)qr[d0]=*reinterpret_cast<const bf16x8*>(&Qw[(long)r32*PITCH+d0*16+hi*8]);
  float mhat=0.f,l_reg=0.f;f32x16 o[2];o[0]=f32x16{};o[1]=f32x16{};
  #define CINIT(X0,X1,tt) do{ const float*fk_=Fl+(tt)*64+4*hi; _Pragma("unroll") for(int g_=0;g_<4;++g_){ const f32x4v a_=*(const f32x4v*)(fk_+8*g_), b_=*(const f32x4v*)(fk_+32+8*g_); \
      _Pragma("unroll") for(int i_=0;i_<4;++i_){ X0[4*g_+i_]=nb-a_[i_]; X1[4*g_+i_]=nb-b_[i_]; } } }while(0)
  #define CINIT4(X,tt,off,g_) do{ const f32x4v a_=*(const f32x4v*)(Fl+(tt)*64+4*hi+(off)+8*(g_)); X[4*(g_)]=nb-a_[0]; X[4*(g_)+1]=nb-a_[1]; X[4*(g_)+2]=nb-a_[2]; X[4*(g_)+3]=nb-a_[3]; PIN(X); }while(0)
  const int qrel=wid*QBLK+r32;
  #define CMASK(P0,P1,t) do{int jb_=(t)-(NT-4); if(jb_>=0)cmask(P0,P1,jb_,qrel,hi);}while(0)
  bool resc=false;
  #define START(P0,P1) do{ const float rm=rowmax(P0,P1); resc=false; \
    { const float dl=max2f(rm,0.f);     \
      mhat=fadd_s(mhat,dl); \
      _Pragma("unroll") for(int r=0;r<16;++r){P0[r]=fsub_s(P0[r],dl);P1[r]=fsub_s(P1[r],dl);} \
      nb=fsub_s(nb,dl); } \
    _Pragma("unroll") for(int r=0;r<16;++r)P0[r]=__builtin_amdgcn_exp2f(P0[r]); }while(0)
  #define RESC() do{ if(resc){ asm volatile("s_waitcnt lgkmcnt(0)":::"memory"); \
      _Pragma("unroll") for(int d_=0;d_<2;++d_) _Pragma("unroll") for(int r=0;r<16;++r)o[d_][r]*=wsf[crow(r,hi)]; } }while(0)
  f32x16 pA0,pA1,pB0,pB1;
  int sl_prev=0,sl_cur=0,sl_next=SLOTB;
  #define ROT() do{sl_prev=sl_cur;sl_cur=sl_next;sl_next=(sl_next==(NSLOT-1)*SLOTB)?0:sl_next+SLOTB;}while(0)
  DMA_K(2,2*SLOTB);
  WAIT_BAR(3);
  CINIT(pA0,pA1,0);
  qkt(pA0,pA1,Kbase,qr,r32,hi);asm volatile("s_nop 15\n\ts_nop 7":"+v"(pA0),"+v"(pA1));CMASK(pA0,pA1,0);
  START(pA0,pA1);
  _Pragma("unroll") for(int r=0;r<16;++r)pA1[r]=__builtin_amdgcn_exp2f(pA1[r]);
  CINIT(pB0,pB1,1);
  WAIT_BAR(0);
  DMA_K(3,0);DMA_V(1,SLOTB);
  ROT();
  kload8(kf,kp0+sl_cur);
  WAIT_BAR(2);
  s16x4 vlo[8],vhi[8]; u32x4 pw0,pw1,pw2,pw3;
  #define PKW(P,B) cvtpk_s(P[B],P[B+1])
  #define PAF(k) __builtin_bit_cast(bf16x8,pw##k)
  #define VFR(i) (bf16x8){vlo[i][0],vlo[i][1],vlo[i][2],vlo[i][3],vhi[i][0],vhi[i][1],vhi[i][2],vhi[i][3]}
  #define PIN(x) asm volatile("":"+v"(x))
  #define MX3(a,b,c) __builtin_fmaxf(__builtin_fmaxf((a),(b)),(c))
  #define GAPA(MF,A0,A1,A2,A3,W0,W1,PW) do{ MF; sacc+=A0; sacc+=A1; sacc+=A2; sacc+=A3; PIN(sacc); W0; W1; PIN(PW); SBAR(); }while(0)
  #define EX(v) __builtin_amdgcn_exp2f(v)
  #define GAPB(MF,X,B,NI) do{ MF; X[B]=EX(X[B]); X[B+1]=EX(X[B+1]); X[B+2]=EX(X[B+2]); X[B+3]=EX(X[B+3]); PIN(X); NI; SBAR(); }while(0)
  #define NIN(G,X,tt,off,g_) do{ if(G){ CINIT4(X,tt,off,g_); } }while(0)
  #define VRD(i) do{ vlo[i]=vtr(vp_+(((i)>>2)*4096+((i)&3)*1024)); vhi[i]=vtr(vp_+(((i)>>2)*4096+((i)&3)*1024+512)); }while(0)
  #define KRD(G,j) do{ if(G){ kload2(kf,kp0+sl_next,j); SBAR(); } }while(0)
  #define STEP(C0,C1,P0,P1,t,GK,GV,GL) do{ SBAR(); \
    const lds_cptr vp_=vp0+sl_prev; \
    VRD(0); SBAR(); float sacc=(P0[0]+P0[1]); \
    GAPA(C0=__builtin_amdgcn_mfma_f32_32x32x16_bf16(kf[0],qr[0],C0,0,0,0), P0[2],P0[3],P0[4],P0[5],     pw0[0]=PKW(P0,0), pw0[1]=PKW(P0,2), pw0); \
    VRD(4); SBAR(); GAPA(C1=__builtin_amdgcn_mfma_f32_32x32x16_bf16(kf[1],qr[0],C1,0,0,0), P0[6],P0[7],P0[8],P0[9],     pw0[2]=PKW(P0,4), pw0[3]=PKW(P0,6), pw0); \
    VRD(1); SBAR(); GAPA(C0=__builtin_amdgcn_mfma_f32_32x32x16_bf16(kf[2],qr[1],C0,0,0,0),   P0[10],P0[11],P0[12],P0[13], pw1[0]=PKW(P0,8), pw1[1]=PKW(P0,10), pw1); \
    VRD(5); SBAR(); GAPA(C1=__builtin_amdgcn_mfma_f32_32x32x16_bf16(kf[3],qr[1],C1,0,0,0),   P0[14],P0[15],P1[0],P1[1],   pw1[2]=PKW(P0,12),pw1[3]=PKW(P0,14), pw1); \
    VRD(2); SBAR(); GAPA(C0=__builtin_amdgcn_mfma_f32_32x32x16_bf16(kf[4],qr[2],C0,0,0,0),   P1[2],P1[3],P1[4],P1[5],     pw2[0]=PKW(P1,0), pw2[1]=PKW(P1,2), pw2); \
    VRD(6); SBAR(); GAPA(C1=__builtin_amdgcn_mfma_f32_32x32x16_bf16(kf[5],qr[2],C1,0,0,0),   P1[6],P1[7],P1[8],P1[9],     pw2[2]=PKW(P1,4), pw2[3]=PKW(P1,6), pw2); \
    VRD(3); SBAR(); GAPA(C0=__builtin_amdgcn_mfma_f32_32x32x16_bf16(kf[6],qr[3],C0,0,0,0),   P1[10],P1[11],P1[12],P1[13], pw3[0]=PKW(P1,8), pw3[1]=PKW(P1,10), pw3); \
    VRD(7); SBAR(); GAPA(C1=__builtin_amdgcn_mfma_f32_32x32x16_bf16(kf[7],qr[3],C1,0,0,0),   P1[14],P1[15],0.f,0.f,       pw3[2]=PKW(P1,12),pw3[3]=PKW(P1,14), pw3); \
    l_reg+=sacc; \
    if(GK){DMA_K((t)+3,sl_cur);} if(GV){DMA_V((t)+1,sl_next);} \
    CMASK(C0,C1,t); \
    { float a=MX3(C0[0],C0[1],C1[0]),b=MX3(C0[2],C0[3],C1[1]); a=MX3(a,C1[2],C1[3]); \
      _Pragma("unroll") for(int r=4;r<16;r+=4){a=MX3(a,C0[r],C0[r+1]);b=MX3(b,C0[r+2],C0[r+3]);a=MX3(a,C1[r],C1[r+1]);b=MX3(b,C1[r+2],C1[r+3]);} \
      float rm=__builtin_fmaxf(a,b); { auto rr=__builtin_amdgcn_permlane32_swap(__float_as_uint(rm),__float_as_uint(rm),false,false); rm=__builtin_fmaxf(__uint_as_float(rr[0]),__uint_as_float(rr[1])); } \
      resc=false; \
      if(__builtin_expect(__any(rm>(float)THRL),0)){ const float dl=__builtin_fmaxf(rm,0.f); mhat+=dl; \
        _Pragma("unroll") for(int r=0;r<16;++r){C0[r]-=dl;C1[r]-=dl;} \
        nb-=dl; \
        const float f=__builtin_amdgcn_exp2f(-dl); l_reg*=f; if(hi==0)wsf[r32]=f; resc=true; } } \
    SBAR(); \
    GAPB(o[0]=__builtin_amdgcn_mfma_f32_32x32x16_bf16(PAF(0),VFR(0),o[0],0,0,0), C0,0, NIN(GL,P0,(t)+1,0,0)); \
    GAPB(o[1]=__builtin_amdgcn_mfma_f32_32x32x16_bf16(PAF(0),VFR(4),o[1],0,0,0), C0,4, NIN(GL,P0,(t)+1,0,1)); \
    KRD(GL,0); GAPB(o[0]=__builtin_amdgcn_mfma_f32_32x32x16_bf16(PAF(1),VFR(1),o[0],0,0,0), C0,8, NIN(GL,P0,(t)+1,0,2)); \
    KRD(GL,1); GAPB(o[1]=__builtin_amdgcn_mfma_f32_32x32x16_bf16(PAF(1),VFR(5),o[1],0,0,0), C0,12, NIN(GL,P0,(t)+1,0,3)); \
    KRD(GL,2); GAPB(o[0]=__builtin_amdgcn_mfma_f32_32x32x16_bf16(PAF(2),VFR(2),o[0],0,0,0), C1,0, NIN(GL,P1,(t)+1,32,0)); \
    KRD(GL,3); GAPB(o[1]=__builtin_amdgcn_mfma_f32_32x32x16_bf16(PAF(2),VFR(6),o[1],0,0,0), C1,4, NIN(GL,P1,(t)+1,32,1)); \
    GAPB(o[0]=__builtin_amdgcn_mfma_f32_32x32x16_bf16(PAF(3),VFR(3),o[0],0,0,0), C1,8, NIN(GL,P1,(t)+1,32,2)); \
    GAPB(o[1]=__builtin_amdgcn_mfma_f32_32x32x16_bf16(PAF(3),VFR(7),o[1],0,0,0), C1,12, NIN(GL,P1,(t)+1,32,3)); \
    }while(0)
  int t=1;
  #undef CMASK
  #define CMASK(P0,P1,t) do{}while(0)
  for(;t+5<NT;t+=2){
    STEP(pB0,pB1,pA0,pA1,t,true,true,true);     WAIT_BAR(2); RESC(); ROT();
    STEP(pA0,pA1,pB0,pB1,t+1,true,true,true);   WAIT_BAR(2); RESC(); ROT();
  }
  #undef CMASK
  #define CMASK(P0,P1,t) do{int jb_=(t)-(NT-4); if(jb_>=0)cmask(P0,P1,jb_,qrel,hi);}while(0)
  #define ENDW(tt) do{ if((tt)+3<NT){WAIT_BAR(2);} else if((tt)+2<NT){WAIT_BAR(1);} else {WAIT_BAR(0);} }while(0)
  for(;t+1<NT;t+=2){
    STEP(pB0,pB1,pA0,pA1,t,(t+3<NT),(t+1<NT),(t+1<NT));       ENDW(t);   RESC(); ROT();
    STEP(pA0,pA1,pB0,pB1,t+1,(t+4<NT),(t+2<NT),(t+2<NT));     ENDW(t+1); RESC(); ROT();
  }
  STEP(pB0,pB1,pA0,pA1,NT-1,false,false,false); RESC();
  { float sacc=pB0[0]+pB0[1]; _Pragma("unroll") for(int r=2;r<16;++r)sacc+=pB0[r]; _Pragma("unroll") for(int r=0;r<16;++r)sacc+=pB1[r]; l_reg+=sacc;
    pw0=(u32x4){PKW(pB0,0),PKW(pB0,2),PKW(pB0,4),PKW(pB0,6)};pw1=(u32x4){PKW(pB0,8),PKW(pB0,10),PKW(pB0,12),PKW(pB0,14)};pw2=(u32x4){PKW(pB1,0),PKW(pB1,2),PKW(pB1,4),PKW(pB1,6)};pw3=(u32x4){PKW(pB1,8),PKW(pB1,10),PKW(pB1,12),PKW(pB1,14)};
    SBAR(); pv(o,vb0+sl_cur,PAF(0),PAF(1),PAF(2),PAF(3)); }
  #undef PKW
  #undef PAF
  #undef VFR
  #undef PIN
  #undef MX3
  #undef GAPA
  #undef GAPB
  #undef NIN
  #undef CINIT
  #undef CINIT4
  #undef EX
  #undef VRD
  #undef KRD
  #undef STEP
  #undef ENDW
  {auto rr=__builtin_amdgcn_permlane32_swap(__float_as_uint(l_reg),__float_as_uint(l_reg),false,false);l_reg=__uint_as_float(rr[0])+__uint_as_float(rr[1]);}
  if(hi==0)wsf[32+r32]=l_reg;asm volatile("s_waitcnt lgkmcnt(0)":::"memory");
  float rli[16];
  #pragma unroll
  for(int r=0;r<16;++r)rli[r]=__builtin_amdgcn_rcpf(wsf[32+crow(r,hi)]);
  { bf16*stg=(bf16*)(shm+LDS_OST)+wid*2048;
    #pragma unroll
    for(int r=0;r<16;++r){const int orow=crow(r,hi);
      #pragma unroll
      for(int d0=0;d0<2;++d0)stg[orow*64+d0*32+r32]=__float2bfloat16(o[d0][r]*rli[r]);}
    asm volatile("s_waitcnt lgkmcnt(0)":::"memory");
    const long grow0=rowbase+q0+wid*QBLK;
    #pragma unroll
    for(int i=0;i<4;++i){const int row=i*8+(lane>>3),ch=lane&7; const u32x4 v=*(const u32x4*)(stg+row*64+ch*8);
      const u32x4 g=*(const u32x4*)(shm+LDS_G+wid*4096+i*1024+lane*16); u32x4 w;
      w.x=cvtpk_s(bf_lo(v.x)*bf_lo(g.x),bf_hi(v.x)*bf_hi(g.x)); w.y=cvtpk_s(bf_lo(v.y)*bf_lo(g.y),bf_hi(v.y)*bf_hi(g.y));
      w.z=cvtpk_s(bf_lo(v.z)*bf_lo(g.z),bf_hi(v.z)*bf_hi(g.z)); w.w=cvtpk_s(bf_lo(v.w)*bf_lo(g.w),bf_hi(v.w)*bf_hi(g.w));
      *(u32x4*)(Y+(grow0+row)*1024+256+h*D+ch*8)=w;} }
  asm volatile("s_waitcnt lgkmcnt(0)\n\ts_barrier":::"memory");
  #undef DMA_K
  #undef DMA_V
  #undef CMASK
  #undef START
  #undef RESC
  #undef ROT
}
#undef SBAR
#undef WAIT_BAR
__device__ __forceinline__ int attn_skip(const Ctx& c, int l, int b, int h, int qb) {
    const unsigned* nrm = (const unsigned*)(c.ws + WS_NORM) + (size_t)l * 128; const float* Fbh = (const float*)(c.ws + WS_FCUM) + (size_t)(b * NHEAD + h) * SEQ;
    const float Bq = sqrtf(__uint_as_float(nrm[(b * NHEAD + h) * 2]) * __uint_as_float(nrm[(b * NHEAD + h) * 2 + 1]));
    const int q0 = qb * QB, NT0 = (q0 + QB) / KVBLK; const float fq0 = Fbh[q0];
    const bool cnd = (c.lane < NT0 - 4) && (2.f * Bq + fq0 - Fbh[64 * c.lane + 63] < -150.f);
    return __builtin_amdgcn_readfirstlane(__popcll(__ballot(cnd))) & ~1;
}
__device__ __forceinline__ void unit_of(int v, int i, int& b, int& h, int& qb) { const int hp = (v & 31) >> 3, j = v & 7; b = v >> 5; h = (i & 1) ? 7 - hp : hp; qb = (i == 0) ? j : (i == 1) ? 8 + j : (i == 2) ? 15 - j : 7 - j; }
__device__ __forceinline__ unsigned attn_skips(const Ctx& c, int l) {
    unsigned pk = 0u;
#pragma unroll
    for (int i = 0; i < 4; ++i) { int b, h, qb; unit_of(c.vcu, i, b, h, qb); pk |= (unsigned)attn_skip(c, l, b, h, qb) << (8 * i); }
    return pk;
}
__device__ __forceinline__ void attn_phase(const Ctx& c, int l, unsigned tspk) {
    for (int v = c.vcu; v < 256; v += c.G) {
#pragma unroll 1
        for (int i = 0; i < 4; ++i) { int b, h, qb; unit_of(v, i, b, h, qb);
            const int tsel = (int)((tspk >> (8 * i)) & 255u);
            const int ts = (v == c.vcu) ? tsel : attn_skip(c, l, b, h, qb);
            attn_unit<24>(b, h, qb, (const bf16*)(c.ws + WS_Z + 1 * ZARR), (const bf16*)(c.ws + WS_Z + 2 * ZARR), (const bf16*)(c.ws + WS_Z + 3 * ZARR),
                         (const unsigned short*)(c.ws + WS_Z + 4 * ZARR), (unsigned short*)(c.ws + WS_XB), (const float*)(c.ws + WS_FCUM), ts, (char*)c.lds); }
    }
}
}

#define LAS __attribute__((address_space(3)))
#define XB_TMO      128
#define XB_XCNT(j)  (256  + 64 * (j))
#define XB_XSUB(j)  (1280 + 64 * (j))
#define XB_XGEN(j)  (2304 + 64 * (j))
#define XB_TOP      3328
#define XB_TOPGEN   3392
#define XCD_BAR_WORDS 3456
#define XB_SPIN_CAP (1u << 18)

__device__ __forceinline__ unsigned xb_ld(unsigned* p)              { return __hip_atomic_load(p, __ATOMIC_RELAXED, __HIP_MEMORY_SCOPE_AGENT); }
__device__ __forceinline__ unsigned xb_add(unsigned* p, unsigned v) { return __hip_atomic_fetch_add(p, v, __ATOMIC_RELAXED, __HIP_MEMORY_SCOPE_AGENT); }
__device__ __forceinline__ unsigned xb_xcc_id() { return (unsigned)__builtin_amdgcn_s_getreg((3 << 11) | 20) & 0xFu; }
#define XB_SPIN(cond, bar) do { unsigned _sp = 0; while (cond) { __builtin_amdgcn_s_sleep(1); \
    if ((++_sp & 255u) == 0u) { if (xb_ld(&(bar)[XB_TMO])) break; if (_sp > XB_SPIN_CAP) { atomicAdd(&(bar)[XB_TMO], 1u); break; } } } } while (0)

struct XcdBarrier {
    unsigned* bar; unsigned x;
    volatile LAS unsigned* st;
};

__device__ __forceinline__ XcdBarrier xcd_barrier_post(unsigned* bar, volatile LAS unsigned* st) {
    XcdBarrier b; b.bar = bar; b.x = xb_xcc_id(); b.st = st;
    if (threadIdx.x == 0) (void)xb_add(&bar[XB_XCNT(b.x)], 1u);
    return b;
}
__device__ __forceinline__ void xcd_barrier_complete(unsigned* bar, unsigned x, unsigned& nloc, unsigned& nx) {
    const unsigned G = gridDim.x * gridDim.y * gridDim.z;
    unsigned sum, cnt, mine, sp = 0u;
    for (;;) {
        sum = 0u; cnt = 0u; mine = 0u;
#pragma unroll
        for (unsigned j = 0; j < 16; ++j) { const unsigned c = xb_ld(&bar[XB_XCNT(j)]); sum += c; cnt += (c > 0u) ? 1u : 0u; mine = (j == x) ? c : mine; }
        if (sum == G) break;
        __builtin_amdgcn_s_sleep(1);
        if ((++sp & 255u) == 0u) { if (xb_ld(&bar[XB_TMO])) break; if (sp > XB_SPIN_CAP) { atomicAdd(&bar[XB_TMO], 1u); break; } }
    }
    nloc = mine > 0u ? mine : 1u; nx = cnt > 0u ? cnt : 1u;
}

__device__ __forceinline__ void xcd_barrier(const XcdBarrier& b) {
    asm volatile("s_waitcnt vmcnt(0)" ::: "memory");
    __syncthreads();
    if (threadIdx.x == 0) {
        unsigned* bar = b.bar;
        __builtin_amdgcn_s_waitcnt(0);
        unsigned nloc = b.st[0], nx = b.st[1];
        if (nloc == 0u) { xcd_barrier_complete(bar, b.x, nloc, nx); b.st[0] = nloc; b.st[1] = nx; }
        const unsigned old = xb_add(&bar[XB_XSUB(b.x)], 1u);
        const unsigned gen = old / nloc;
        if (old + 1u == (gen + 1u) * nloc) {
            __builtin_amdgcn_fence(__ATOMIC_RELEASE, "agent");
            asm volatile("s_waitcnt vmcnt(0)" ::: "memory");
            const unsigned og = xb_add(&bar[XB_TOP], 1u);
            const unsigned tg = og / nx;
            if (og + 1u == (tg + 1u) * nx) xb_add(&bar[XB_TOPGEN], 1u);
            else XB_SPIN(xb_ld(&bar[XB_TOPGEN]) == tg, bar);
            __builtin_amdgcn_fence(__ATOMIC_ACQUIRE, "agent");
            xb_add(&bar[XB_XGEN(b.x)], 1u);
            asm volatile("s_waitcnt vmcnt(0)" ::: "memory");
        } else {
            XB_SPIN(xb_ld(&bar[XB_XGEN(b.x)]) == gen, bar);
            __builtin_amdgcn_fence(__ATOMIC_ACQUIRE, "agent");
            asm volatile("s_waitcnt vmcnt(0)" ::: "memory");
        }
    }
    __syncthreads();
}

constexpr int PH_PER_LAYER = 7, N_PHASES = NLAYER * PH_PER_LAYER + 1;
__global__ void __launch_bounds__(512, 2) mega_fwd(Args args) {
    __shared__ __attribute__((aligned(16))) unsigned char lds_raw[LDS_BYTES];
    cg::grid_group grid = cg::this_grid();
    Ctx c;
    c.a = &args; c.zero = 0;
    c.out = args.out; c.ws = args.ws; c.lds = lds_raw;
    c.tid = threadIdx.x; c.lane = c.tid & 63; c.wave = __builtin_amdgcn_readfirstlane(c.tid >> 6);
    c.G = gridDim.x; { const int bx = blockIdx.x; c.vcu = (c.G % 8 == 0) ? (bx % 8) * (c.G / 8) + bx / 8 : bx; }
    PG8_LAS unsigned char* lds3 = (PG8_LAS unsigned char*)lds_raw;
    volatile LAS unsigned* bst = (volatile LAS unsigned*)(lds3 + (LDS_BYTES - 64));
    if (threadIdx.x < 16) bst[threadIdx.x] = 0u;
    __syncthreads();
    XcdBarrier xbar = xcd_barrier_post((unsigned*)(args.ws), bst);
    grid.sync();
    bf16_t* XB = (bf16_t*)(c.ws + WS_XB);
    for (int ph = args.ph_lo; ph < args.ph_hi; ++ph) {
        const int l = ph / PH_PER_LAYER, k = ph % PH_PER_LAYER;
        { int t_ = threadIdx.x; asm volatile("" : "+v"(t_)); c.tid = t_; c.lane = t_ & 63; c.wave = __builtin_amdgcn_readfirstlane(t_ >> 6);
          int z_ = 0; asm volatile("" : "+s"(z_)); c.zero = z_;
          int bx = blockIdx.x; asm volatile("" : "+s"(bx)); c.vcu = (c.G % 8 == 0) ? (bx % 8) * (c.G / 8) + bx / 8 : bx; }
#ifndef REPMASK
#define REPMASK 0
#endif
#ifndef PHMASK
#define PHMASK 255
#endif
        if (k == 0) {
            if ((REPMASK & 512) && l < NLAYER) { phase_rows(c, 0); __syncthreads(); asm volatile("s_waitcnt vmcnt(0)" ::: "memory"); }
            if (PHMASK & 1) phase_rows(c, l);
        } else if (k == 1) {
            pg8::Gemm g{XB, (const bf16_t*)(c.ws + WS_WIN), MTOK, 6144, 1024}; pg8::StaticOrder S; S.init(MTOK, 6144, c.G, (int)blockIdx.x);
            pg8::EpiZ E{(bf16_t*)(c.ws + WS_Z), c.inp(IN_BIN) + (size_t)l * DIN};
            if (PHMASK & 2) pg8::gemm_phase<pg8::EpiZ, pg8::StaticOrder, true, true>(lds3, g, S, E);
            if (REPMASK & 2) { __syncthreads(); pg8::gemm_phase<pg8::EpiZ, pg8::StaticOrder, true, true>(lds3, g, S, E); }
        } else if (k == 2) {
            if (PHMASK & 4) { for (int tile = c.vcu; tile < 256; tile += c.G) norm_unit(c, l, tile);
            for (int bh = c.vcu; bh < 64; bh += c.G) fcum_unit(c, bh);
            for (int tile = c.vcu; tile < 256; tile += c.G) pool_tile(c, l, tile);
            ssm2_pass<false>(c, l); }
            if (REPMASK & 4) { __syncthreads(); for (int tile = c.vcu; tile < 256; tile += c.G) pool_tile(c, l, tile); }
            if (REPMASK & 16) { __syncthreads(); ssm2_pass<false>(c, l); }
        } else if (k == 3) {
            const unsigned tspk = fox2::attn_skips(c, l);
            if (PHMASK & 8) ssm2_pass<true>(c, l);
            if (REPMASK & 8) { __syncthreads(); ssm2_pass<true>(c, l); }
            __syncthreads();
#ifndef FOX_TUNED
#define FOX_TUNED 1
#endif
            if (PHMASK & 128) { if (FOX_TUNED) fox2::attn_phase(c, l, tspk); else fox::attn_phase(c); }
            if (REPMASK & 128) { __syncthreads(); fox2::attn_phase(c, l, tspk); }
        } else if (k == 4) {
            pg8::Gemm g{(const bf16_t*)(c.ws + WS_Z), (const bf16_t*)(c.ws + WS_WGLU), MTOK, 256, 256}; pg8::StaticOrder S; S.init(MTOK, 256, c.G, (int)blockIdx.x);
            pg8::EpiGlu E{(const bf16_t*)(c.ws + WS_Z), (const bf16_t*)(c.ws + WS_Z + 5 * ZARR), c.inp(IN_BGLU) + (size_t)l * 256, XB};
            if (PHMASK & 16) pg8::gemm_phase<pg8::EpiGlu, pg8::StaticOrder, true, true>(lds3, g, S, E);
            if (REPMASK & 256) { __syncthreads(); pg8::gemm_phase<pg8::EpiGlu, pg8::StaticOrder, true, true>(lds3, g, S, E); }
        } else if (k == 5) {
            pg8::Gemm g{XB, (const bf16_t*)(c.ws + WS_WUP), MTOK, 1024, 1024}; pg8::StaticOrder S; S.init(MTOK, 1024, c.G, (int)blockIdx.x);
            pg8::EpiUp E{(const bf16_t*)(c.ws + WS_Z + 6 * ZARR), (bf16_t*)(c.ws + WS_Z + 1 * ZARR)};
            int nrep_ = (REPMASK & 32) ? 2 : 1; asm volatile("" : "+s"(nrep_));
            for (int r_ = 0; r_ < nrep_; ++r_) { if (PHMASK & 32) pg8::gemm_phase<pg8::EpiUp, pg8::StaticOrder, true, true>(lds3, g, S, E); __syncthreads(); }
        } else {
            pg8::Gemm g{(const bf16_t*)(c.ws + WS_Z + 1 * ZARR), (const bf16_t*)(c.ws + WS_WOUT), MTOK, 1024, 1024}; pg8::StaticOrder S; S.init(MTOK, 1024, c.G, (int)blockIdx.x);
            pg8::EpiOut E{(l == 0) ? c.inp(IN_X) : (const float*)c.out, c.out, (l == 0) ? (const float*)nullptr : (const float*)(c.ws + WS_STATS),
                          c.inp(IN_LNG) + (size_t)(l > 0 ? l - 1 : 0) * DM, c.inp(IN_LNB) + (size_t)(l > 0 ? l - 1 : 0) * DM};
            if (PHMASK & 64) pg8::gemm_phase<pg8::EpiOut, pg8::StaticOrder, true, true>(lds3, g, S, E);
        }
        for (int rep_ = 0; rep_ < ((REPMASK & 64) ? 2 : 1); ++rep_)
        if (ph + 1 < args.ph_hi) {
            {
                xcd_barrier(xbar);
            }
        }
    }
}

extern "C" void kernel_launch(void* const* d_in, const int* in_sizes, int n_in, void* d_out, int out_size, void* d_ws, size_t ws_size, hipStream_t stream) {
    static int grid = 0;
    if (grid == 0) {
        if (n_in != 21 || out_size != MTOK * DM || ws_size < WS_END) { fprintf(stderr, "kernel_launch: unexpected shapes (n_in %d out %d ws %zu)\n", n_in, out_size, ws_size); grid = -1; return; }
        int dev = 0, cus = 0, per_cu = 0;
        (void)hipGetDevice(&dev); (void)hipDeviceGetAttribute(&cus, hipDeviceAttributeMultiprocessorCount, dev);
        if (hipOccupancyMaxActiveBlocksPerMultiprocessor(&per_cu, (const void*)mega_fwd, 512, 0) != hipSuccess || per_cu < 1) per_cu = 1;
        (void)hipGetLastError();
        grid = cus * per_cu;
    }
    if (grid < 0) return;
    (void)hipMemsetAsync(d_ws, 0, 16384, stream);
    Args a{};
    for (int i = 0; i < 21; ++i) a.in[i] = (const float*)d_in[i];
    a.out = (float*)d_out; a.ws = (unsigned char*)d_ws;
#if MK_ONE_LAUNCH
    a.ph_lo = 0; a.ph_hi = N_PHASES;
    void* kargs[] = {&a};
    hipError_t e = hipLaunchCooperativeKernel((const void*)mega_fwd, dim3(grid), dim3(512), kargs, 0, stream);
    if (e != hipSuccess) fprintf(stderr, "cooperative launch failed: %s (grid %d)\n", hipGetErrorString(e), grid);
#else
    for (int ph = 0; ph < N_PHASES; ++ph) { a.ph_lo = ph; a.ph_hi = ph + 1; hipLaunchKernelGGL(mega_fwd, dim3(grid), dim3(512), 0, stream, a); }
#endif
}
```
